# Optimizing an MI355X kernel written in HIP

```python
import jax
import jax.numpy as jnp
from jax import lax
import numpy as np

D_MODEL = 1024
BATCH = 32
SEQ = 2048
DEPTH = 1

HEAD_DIM = 64
FOX_HEADS = D_MODEL // (2 * HEAD_DIM)
NSA_HEADS = D_MODEL // (2 * HEAD_DIM)
NSA_KV_HEADS = max(1, NSA_HEADS // 4)
MIX_WIDTH = (FOX_HEADS + NSA_HEADS) * HEAD_DIM
CMP_LEN = 32
CMP_STRIDE = 16
CMP_HIDDEN = 2 * HEAD_DIM
SEL_BLOCK = 64
SEL_TOPK = 16
WINDOW = 512
Q_BLOCK = 128
SEL_CHUNK = 16
N_BRANCH = 3
MEM_LEN = 256
CROSS_HEADS = 4
CROSS_HEAD_DIM = D_MODEL // CROSS_HEADS
MLP_HIDDEN = 4 * D_MODEL
ROPE_THETA = 10000.0
RMS_EPS = 1e-6
NEG_BIG = -1e30
FORCE_SCORE = 1e4

FOX_QKV = FOX_HEADS * HEAD_DIM
NSA_Q = NSA_HEADS * HEAD_DIM
NSA_KV = NSA_KV_HEADS * HEAD_DIM
IN_SPLITS = (FOX_QKV, FOX_QKV, FOX_QKV, FOX_HEADS, NSA_Q, NSA_KV, NSA_KV, NSA_KV, NSA_KV, NSA_KV, NSA_KV, NSA_HEADS * N_BRANCH)
IN_COLS = sum(IN_SPLITS)

kernel_name = 'hybrid_fox_nsa_sandwich_layer'


def _rms_norm(x, g):
    xf = x.astype(jnp.float32)
    y = xf * lax.rsqrt(jnp.mean(xf * xf, axis=-1, keepdims=True) + RMS_EPS)
    return (y * g.astype(jnp.float32)).astype(x.dtype)


def _rope(x, pos):
    half = x.shape[-1] // 2
    inv = ROPE_THETA ** (-jnp.arange(half, dtype=jnp.float32) / half)
    ang = pos.astype(jnp.float32)[:, None] * inv[None, :]
    cos, sin = jnp.cos(ang), jnp.sin(ang)
    xf = x.astype(jnp.float32)
    x1, x2 = xf[..., :half], xf[..., half:]
    return jnp.concatenate([x1 * cos - x2 * sin, x2 * cos + x1 * sin], axis=-1).astype(x.dtype)


def _split_cols(a, sizes):
    out, lo = [], 0
    for s in sizes:
        out.append(a[..., lo:lo + s])
        lo += s
    return out


def _fox_attention(q, k, v, log_f):
    T = q.shape[2]
    scale = q.shape[-1] ** -0.5
    c = jnp.cumsum(log_f, axis=-1)
    outs = []
    for i in range(T // Q_BLOCK):
        lo, hi = i * Q_BLOCK, (i + 1) * Q_BLOCK
        s = jnp.einsum('bhqd,bhkd->bhqk', q[:, :, lo:hi], k[:, :, :hi]).astype(jnp.float32) * scale
        s = s + c[:, :, lo:hi, None] - c[:, :, None, :hi]
        causal = jnp.arange(lo, hi)[:, None] >= jnp.arange(hi)[None, :]
        s = jnp.where(causal, s, -jnp.inf)
        p = jax.nn.softmax(s, axis=-1).astype(v.dtype)
        outs.append(jnp.einsum('bhqk,bhkd->bhqd', p, v[:, :, :hi]))
    return jnp.concatenate(outs, axis=2)


def _nsa_attention(q, k_cmp, v_cmp, k_slc, v_slc, k_win, v_win, gate_logits,
                   w_ck1, w_ck2, w_cv1, w_cv2, pe_k, pe_v):
    B, T, H, dh = q.shape
    G = k_cmp.shape[1]
    R = H // G
    scale = dh ** -0.5
    pos = jnp.arange(T)
    qg = q.reshape(B, T, G, R, dh).transpose(0, 2, 3, 1, 4)

    n_cmp = (T - CMP_LEN) // CMP_STRIDE + 1
    starts = jnp.arange(n_cmp) * CMP_STRIDE
    blk_idx = starts[:, None] + jnp.arange(CMP_LEN)[None, :]

    def compress(a, pe, w1, w2):
        blk = a[:, :, blk_idx] + pe
        flat = blk.reshape(B, G, n_cmp, CMP_LEN * dh)
        return jax.nn.silu(flat @ w1) @ w2

    kc = compress(k_cmp, pe_k, w_ck1, w_ck2)
    vc = compress(v_cmp, pe_v, w_cv1, w_cv2)
    s_c = jnp.einsum('bgrtd,bgnd->bgrtn', qg, kc).astype(jnp.float32) * scale
    valid_c = (starts + CMP_LEN - 1)[None, :] <= pos[:, None]
    s_c = jnp.where(valid_c, s_c, NEG_BIG)
    p_c = jax.nn.softmax(s_c, axis=-1) * jnp.any(valid_c, axis=-1)[:, None].astype(jnp.float32)
    o_cmp = jnp.einsum('bgrtn,bgnd->bgrtd', p_c.astype(vc.dtype), vc)

    n_sel = T // SEL_BLOCK
    sel_lo = jnp.arange(n_sel) * SEL_BLOCK
    overlap = ((starts[:, None] < sel_lo[None, :] + SEL_BLOCK)
               & (starts[:, None] + CMP_LEN > sel_lo[None, :])).astype(jnp.float32)
    imp = jnp.einsum('bgrtn,nj->bgtj', p_c, overlap)
    cur = pos // SEL_BLOCK
    jb = jnp.arange(n_sel)
    is_cur = jb[None, :] == cur[:, None]
    is_fixed = (jb[None, :] == 0) | (jb[None, :] == cur[:, None] - 1)
    imp = jnp.where(is_cur, 2.0 * FORCE_SCORE, jnp.where(is_fixed, FORCE_SCORE, imp))
    imp = jnp.where(jb[None, :] <= cur[:, None], imp, -1.0)
    n_top = min(SEL_TOPK, n_sel)
    _, top_idx = lax.top_k(imp, n_top)

    q_rot = _rope(qg, pos)
    ks_blk = _rope(k_slc, pos).reshape(B, G, n_sel, SEL_BLOCK, dh)
    vs_blk = v_slc.reshape(B, G, n_sel, SEL_BLOCK, dh)
    n_ch = T // SEL_CHUNK
    q_ch = q_rot.reshape(B, G, R, n_ch, SEL_CHUNK, dh).transpose(3, 0, 1, 2, 4, 5)
    i_ch = top_idx.reshape(B, G, n_ch, SEL_CHUNK, n_top).transpose(2, 0, 1, 3, 4)
    t_ch = pos.reshape(n_ch, SEL_CHUNK)
    bi = jnp.arange(B)[:, None, None, None]
    gi = jnp.arange(G)[None, :, None, None]
    n_keys = n_top * SEL_BLOCK

    def sel_step(args):
        qc, ic, tc = args
        kg = ks_blk[bi, gi, ic].reshape(B, G, SEL_CHUNK, n_keys, dh)
        vg = vs_blk[bi, gi, ic].reshape(B, G, SEL_CHUNK, n_keys, dh)
        kpos = (ic[..., None] * SEL_BLOCK + jnp.arange(SEL_BLOCK)).reshape(B, G, SEL_CHUNK, n_keys)
        mask = kpos <= tc[:, None]
        s = jnp.einsum('bgrcd,bgckd->bgrck', qc, kg).astype(jnp.float32) * scale
        s = jnp.where(mask[:, :, None], s, -jnp.inf)
        p = jax.nn.softmax(s, axis=-1).astype(vg.dtype)
        return jnp.einsum('bgrck,bgckd->bgrcd', p, vg)

    o_slc = lax.map(sel_step, (q_ch, i_ch, t_ch))
    o_slc = o_slc.transpose(1, 2, 3, 0, 4, 5).reshape(B, G, R, T, dh)

    pad = ((0, 0), (0, 0), (WINDOW, 0), (0, 0))
    kw = jnp.pad(_rope(k_win, pos), pad)
    vw = jnp.pad(v_win, pad)
    n_qb = T // Q_BLOCK
    q_blk = q_rot.reshape(B, G, R, n_qb, Q_BLOCK, dh).transpose(3, 0, 1, 2, 4, 5)

    def win_step(args):
        qb, i = args
        lo = i * Q_BLOCK
        kb = lax.dynamic_slice_in_dim(kw, lo, Q_BLOCK + WINDOW, axis=2)
        vb = lax.dynamic_slice_in_dim(vw, lo, Q_BLOCK + WINDOW, axis=2)
        qpos = lo + jnp.arange(Q_BLOCK)
        kpos = lo - WINDOW + jnp.arange(Q_BLOCK + WINDOW)
        mask = ((kpos[None, :] <= qpos[:, None]) & (kpos[None, :] > qpos[:, None] - WINDOW)
                & (kpos[None, :] >= 0))
        s = jnp.einsum('bgrqd,bgkd->bgrqk', qb, kb).astype(jnp.float32) * scale
        s = jnp.where(mask, s, -jnp.inf)
        p = jax.nn.softmax(s, axis=-1).astype(vb.dtype)
        return jnp.einsum('bgrqk,bgkd->bgrqd', p, vb)

    o_win = lax.map(win_step, (q_blk, jnp.arange(n_qb)))
    o_win = o_win.transpose(1, 2, 3, 0, 4, 5).reshape(B, G, R, T, dh)

    gts = jax.nn.sigmoid(gate_logits.astype(jnp.float32)).astype(q.dtype)
    gts = gts.reshape(B, T, G, R, N_BRANCH).transpose(0, 2, 3, 1, 4)[..., None]
    o = gts[..., 0, :] * o_cmp + gts[..., 1, :] * o_slc + gts[..., 2, :] * o_win
    return o.transpose(0, 3, 1, 2, 4).reshape(B, T, H * dh)


def _hybrid_mixer(n, w_in, b_forget, w_ck1, w_ck2, w_cv1, w_cv2, pe_k, pe_v, w_out):
    B, T, _ = n.shape
    proj = n @ w_in
    fq, fk, fv, ff, nq, kc, vc, ks, vs, kw, vw, ng = _split_cols(proj, IN_SPLITS)

    def heads(a, h):
        return a.reshape(B, T, h, HEAD_DIM).transpose(0, 2, 1, 3)

    log_f = jax.nn.log_sigmoid((ff + b_forget).astype(jnp.float32)).transpose(0, 2, 1)
    o_fox = _fox_attention(heads(fq, FOX_HEADS), heads(fk, FOX_HEADS), heads(fv, FOX_HEADS), log_f)
    o_fox = o_fox.transpose(0, 2, 1, 3).reshape(B, T, FOX_QKV)
    o_nsa = _nsa_attention(nq.reshape(B, T, NSA_HEADS, HEAD_DIM),
                           heads(kc, NSA_KV_HEADS), heads(vc, NSA_KV_HEADS),
                           heads(ks, NSA_KV_HEADS), heads(vs, NSA_KV_HEADS),
                           heads(kw, NSA_KV_HEADS), heads(vw, NSA_KV_HEADS),
                           ng.reshape(B, T, NSA_HEADS, N_BRANCH),
                           w_ck1, w_ck2, w_cv1, w_cv2, pe_k, pe_v)
    return jnp.concatenate([o_fox, o_nsa], axis=-1) @ w_out


def _memory_cross_attention(n, m, w_q, w_kv, w_o):
    B, T, D = n.shape
    M = m.shape[1]
    q = (n @ w_q).reshape(B, T, CROSS_HEADS, CROSS_HEAD_DIM)
    kv = (m @ w_kv).reshape(B, M, 2, CROSS_HEADS, CROSS_HEAD_DIM)
    k, v = kv[:, :, 0], kv[:, :, 1]
    s = jnp.einsum('bthd,bmhd->bhtm', q, k).astype(jnp.float32) * (CROSS_HEAD_DIM ** -0.5)
    p = jax.nn.softmax(s, axis=-1).astype(v.dtype)
    o = jnp.einsum('bhtm,bmhd->bthd', p, v).reshape(B, T, D)
    return o @ w_o


def _sq_relu_mlp(n, w_up, w_down):
    return jnp.square(jax.nn.relu(n @ w_up)) @ w_down


def setup_inputs(seed: int = 0) -> dict:
    key = jax.random.key(seed)
    ks = jax.random.split(key, 23)
    f32 = jnp.float32
    L = DEPTH

    def dense(k, shape, fan_in):
        return jax.random.normal(k, shape, f32) * fan_in ** -0.5

    def gain(k, dim):
        return 1.0 + 0.05 * jax.random.normal(k, (L, dim), f32)

    return {
        'x': jax.random.normal(ks[0], (BATCH, SEQ, D_MODEL), f32),
        'mem': jax.random.normal(ks[1], (BATCH, MEM_LEN, D_MODEL), f32),
        'g_mix_pre': gain(ks[2], D_MODEL),
        'w_in': dense(ks[3], (L, D_MODEL, IN_COLS), D_MODEL),
        'b_forget': jax.random.uniform(ks[4], (L, FOX_HEADS), f32, 1.0, 5.0),
        'w_ck1': dense(ks[5], (L, CMP_LEN * HEAD_DIM, CMP_HIDDEN), CMP_LEN * HEAD_DIM),
        'w_ck2': dense(ks[6], (L, CMP_HIDDEN, HEAD_DIM), CMP_HIDDEN),
        'w_cv1': dense(ks[7], (L, CMP_LEN * HEAD_DIM, CMP_HIDDEN), CMP_LEN * HEAD_DIM),
        'w_cv2': dense(ks[8], (L, CMP_HIDDEN, HEAD_DIM), CMP_HIDDEN),
        'pe_k': 0.1 * jax.random.normal(ks[9], (L, CMP_LEN, HEAD_DIM), f32),
        'pe_v': 0.1 * jax.random.normal(ks[10], (L, CMP_LEN, HEAD_DIM), f32),
        'w_mix_out': dense(ks[11], (L, MIX_WIDTH, D_MODEL), MIX_WIDTH),
        'g_mix_post': gain(ks[12], D_MODEL),
        'g_x_pre': gain(ks[13], D_MODEL),
        'g_mem': gain(ks[14], D_MODEL),
        'w_xq': dense(ks[15], (L, D_MODEL, D_MODEL), D_MODEL),
        'w_xkv': dense(ks[16], (L, D_MODEL, 2 * D_MODEL), D_MODEL),
        'w_xo': dense(ks[17], (L, D_MODEL, D_MODEL), D_MODEL),
        'g_x_post': gain(ks[18], D_MODEL),
        'g_mlp_pre': gain(ks[19], D_MODEL),
        'w_up': dense(ks[20], (L, D_MODEL, MLP_HIDDEN), D_MODEL),
        'w_down': dense(ks[21], (L, MLP_HIDDEN, D_MODEL), MLP_HIDDEN),
        'g_mlp_post': gain(ks[22], D_MODEL),
    }


def reference(x, mem, g_mix_pre, w_in, b_forget, w_ck1, w_ck2, w_cv1, w_cv2, pe_k, pe_v,
              w_mix_out, g_mix_post, g_x_pre, g_mem, w_xq, w_xkv, w_xo, g_x_post,
              g_mlp_pre, w_up, w_down, g_mlp_post):
    h = x
    for l in range(DEPTH):
        n = _rms_norm(h, g_mix_pre[l])
        mix = _hybrid_mixer(n, w_in[l], b_forget[l], w_ck1[l], w_ck2[l], w_cv1[l], w_cv2[l],
                            pe_k[l], pe_v[l], w_mix_out[l])
        h = h + _rms_norm(mix, g_mix_post[l])
        n = _rms_norm(h, g_x_pre[l])
        m = _rms_norm(mem, g_mem[l])
        h = h + _rms_norm(_memory_cross_attention(n, m, w_xq[l], w_xkv[l], w_xo[l]), g_x_post[l])
        n = _rms_norm(h, g_mlp_pre[l])
        h = h + _rms_norm(_sq_relu_mlp(n, w_up[l], w_down[l]), g_mlp_post[l])
    return h
```

```cpp
#include <hip/hip_runtime.h>
#include <hip/hip_cooperative_groups.h>
#include <cstdio>
#include <cstdint>
namespace cg = cooperative_groups;

#ifndef MK_ONE_LAUNCH
#define MK_ONE_LAUNCH 1
#endif

#define LAS __attribute__((address_space(3)))
typedef unsigned short bf16_t;
typedef short bf16x8 __attribute__((ext_vector_type(8)));
typedef short s16x4 __attribute__((ext_vector_type(4)));
typedef float f32x2 __attribute__((ext_vector_type(2)));
typedef float f32x4 __attribute__((ext_vector_type(4)));
typedef float f32x16 __attribute__((ext_vector_type(16)));
typedef unsigned u32x2 __attribute__((ext_vector_type(2)));
typedef unsigned u32x4 __attribute__((ext_vector_type(4)));

constexpr int BATCH = 32, SEQ = 2048, DM = 1024, MTOK = BATCH * SEQ;
constexpr int NPROJ = 3072;
constexpr int MEMLEN = 256, MMEM = BATCH * MEMLEN;
constexpr int FF = 4096;
constexpr float RMS_EPS = 1e-6f;
constexpr int C_FQ = 0, C_FK = 512, C_FV = 1024, C_NQ = 1536, C_KC = 2048, C_VC = 2176, C_KS = 2304, C_VS = 2432, C_KW = 2560, C_VW = 2688, C_FF = 2816, C_NG = 2824;

constexpr size_t MiB = 1u << 20;
constexpr size_t WS_CTL = 0;
constexpr size_t WS_WIN = 2 * MiB;
constexpr size_t WS_WOUT = 8 * MiB;
constexpr size_t WS_WXQ = 10 * MiB;
constexpr size_t WS_WXKV = 12 * MiB;
constexpr size_t WS_WXO = 16 * MiB;
constexpr size_t WS_WUP = 18 * MiB;
constexpr size_t WS_WDN = 26 * MiB;
constexpr size_t WS_WC1 = 34 * MiB;
constexpr size_t WS_ROPE = 36 * MiB;
constexpr size_t WS_BIAS1 = 37 * MiB;
constexpr size_t WS_FG = 40 * MiB;
constexpr size_t WS_C2 = 48 * MiB;
constexpr size_t WS_Y = 50 * MiB;
constexpr size_t WS_KC = 82 * MiB;
constexpr size_t WS_MN = 84 * MiB;
constexpr size_t WS_KX = 100 * MiB;
constexpr size_t WS_VT = 116 * MiB;
constexpr size_t WS_N = 132 * MiB;
constexpr size_t WS_G = 260 * MiB;
constexpr size_t WS_AO = 388 * MiB;
constexpr size_t WS_PROJ = 516 * MiB;
constexpr size_t WS_QX = 516 * MiB;
constexpr size_t WS_S = 644 * MiB;
constexpr size_t WS_U = 388 * MiB;
constexpr size_t WS_END = 900 * MiB;

constexpr int CW_QUEUE = 64;
constexpr int CW_XCNT = 16384;
constexpr int CW_NORM = 8192;

__device__ __forceinline__ unsigned pk2(float lo, float hi) {
    typedef __bf16 b2 __attribute__((ext_vector_type(2)));
    f32x2 v = {lo, hi}; b2 b = __builtin_convertvector(v, b2); return __builtin_bit_cast(unsigned, b);
}
__device__ __forceinline__ float bf_lo(unsigned u) { return __uint_as_float(u << 16); }
__device__ __forceinline__ float bf_hi(unsigned u) { return __uint_as_float(u & 0xffff0000u); }
__device__ __forceinline__ float wave_sum(float v) {
#pragma unroll
    for (int o = 1; o < 64; o <<= 1) v += __shfl_xor(v, o);
    return v;
}
__device__ __forceinline__ float wave_max(float v) {
#pragma unroll
    for (int o = 1; o < 64; o <<= 1) v = fmaxf(v, __shfl_xor(v, o));
    return v;
}

namespace pg8 {
constexpr int BM = 256, BK = 64, HALF = 128, HTB = HALF * BK * 2, STAGE_BYTES = 8 * HTB, NXCD = 8, WGM = 4;

__host__ __device__ __forceinline__ int lds_byte(int r, int c) { const int st = (r >> 4) * 2 + (c >> 5), rr = r & 15, cc = c & 31, ob = rr * 64 + cc * 2; return st * 1024 + (ob ^ (((ob >> 9) & 1) << 5)); }
__host__ __device__ __forceinline__ void stage_rc(int b, int& R, int& C) { const int st = b / 1024, sb = b % 1024, swz = sb ^ (((sb >> 9) & 1) << 5); R = (st >> 1) * 16 + swz / 64; C = (st & 1) * 32 + (swz % 64) / 2; }
__host__ __device__ __forceinline__ int perm32(int rho) { const int n = rho >> 4, i = rho & 15; return 8 * (i >> 2) + 4 * n + (i & 3); }

struct Unit { int pm, pn, z; size_t aoff, boff, coff; };
struct Gemm { const char* A; const char* Bt; unsigned lda, ldb; unsigned kstepA, kstepB; int K; };

struct StaticOrder {
    int nM, nN, nwg, G, c; size_t lda, ldb, ldc;
    __device__ void init(int M, int N, int G_, int c_, size_t lda_, size_t ldb_, size_t ldc_) { nM = M / BM; nN = N / BM; nwg = nM * nN; G = G_; c = c_; lda = lda_; ldb = ldb_; ldc = ldc_; }
    __device__ bool next(int i, Unit& u) const {
        const long L = (long)i * G + c; if (L >= nwg) return false;
        int wgid = (int)L; { const int q = nwg / NXCD, r = nwg % NXCD, xcd = wgid % NXCD, off = wgid / NXCD; wgid = (xcd < r ? xcd * (q + 1) : r * (q + 1) + (xcd - r) * q) + off; }
        const int nig = WGM * nN, gid = wgid / nig, fm = gid * WGM, gsz = (nM - fm) < WGM ? (nM - fm) : WGM;
        u.pm = fm + ((wgid % nig) % gsz); u.pn = (wgid % nig) / gsz; u.z = 0;
        u.aoff = (size_t)u.pm * BM * lda * 2; u.boff = (size_t)u.pn * BM * ldb * 2; u.coff = (size_t)u.pm * BM * ldc + (size_t)u.pn * BM;
        return true;
    }
};

template <int ACT  > struct EpiBf16 {
    static constexpr bool PERM = true;
    bf16_t* O; size_t ldc; const float* rscale = nullptr;
    __device__ __forceinline__ void operator()(const f32x4 (&acc)[2][2][4][2], const Unit& u, int wr, int wc, int fr, int fq) const {
        bf16_t* base = O + u.coff + (size_t)(wr * 64 + fr) * ldc + wc * 32 + 8 * fq;
#pragma unroll
        for (int ai = 0; ai < 2; ++ai)
#pragma unroll
            for (int m = 0; m < 4; ++m) { bf16_t* rowp = base + (size_t)(ai * HALF + m * 16) * ldc;
                const float rs = rscale ? rscale[u.pm * BM + wr * 64 + fr + ai * HALF + m * 16] : 1.f;
#pragma unroll
                for (int bj = 0; bj < 2; ++bj) { f32x4 v0 = acc[ai][bj][m][0] * rs, v1 = acc[ai][bj][m][1] * rs;
                    if (ACT == 1) {
#pragma unroll
                        for (int i = 0; i < 4; ++i) { const float a = fmaxf(v0[i], 0.f), b = fmaxf(v1[i], 0.f); v0[i] = a * a; v1[i] = b * b; } }
                    u32x4 w; w.x = pk2(v0[0], v0[1]); w.y = pk2(v0[2], v0[3]); w.z = pk2(v1[0], v1[1]); w.w = pk2(v1[2], v1[3]);
                    *(u32x4*)(rowp + bj * HALF) = w; } }
    }
};
struct EpiProj {
    static constexpr bool PERM = true;
    bf16_t* O; float* FG;
    __device__ __forceinline__ void operator()(const f32x4 (&acc)[2][2][4][2], const Unit& u, int wr, int wc, int fr, int fq) const {
        if (u.pn < 11) {
            bf16_t* base = O + u.coff + (size_t)(wr * 64 + fr) * NPROJ + wc * 32 + 8 * fq;
#pragma unroll
            for (int ai = 0; ai < 2; ++ai)
#pragma unroll
                for (int m = 0; m < 4; ++m) { bf16_t* rowp = base + (size_t)(ai * HALF + m * 16) * NPROJ;
#pragma unroll
                    for (int bj = 0; bj < 2; ++bj) { const f32x4 v0 = acc[ai][bj][m][0], v1 = acc[ai][bj][m][1];
                        u32x4 w; w.x = pk2(v0[0], v0[1]); w.y = pk2(v0[2], v0[3]); w.z = pk2(v1[0], v1[1]); w.w = pk2(v1[2], v1[3]);
                        *(u32x4*)(rowp + bj * HALF) = w; } }
        } else if (wc == 0) {
            float* base = FG + (size_t)(u.pm * BM + wr * 64 + fr) * 32 + 8 * fq;
#pragma unroll
            for (int ai = 0; ai < 2; ++ai)
#pragma unroll
                for (int m = 0; m < 4; ++m) { float* rowp = base + (size_t)(ai * HALF + m * 16) * 32;
                    *(f32x4*)(rowp) = acc[ai][0][m][0]; *(f32x4*)(rowp + 4) = acc[ai][0][m][1]; }
        }
    }
};
struct EpiF32 {
    static constexpr bool PERM = false;
    float* O; size_t ldc; float scale;
    __device__ __forceinline__ void operator()(const f32x4 (&acc)[2][2][4][2], const Unit& u, int wr, int wc, int fr, int fq) const {
        float* base = O + u.coff + (size_t)(wr * 64 + fr) * ldc + wc * 32 + 4 * fq;
#pragma unroll
        for (int ai = 0; ai < 2; ++ai)
#pragma unroll
            for (int m = 0; m < 4; ++m) { float* rowp = base + (size_t)(ai * HALF + m * 16) * ldc;
#pragma unroll
                for (int bj = 0; bj < 2; ++bj)
#pragma unroll
                    for (int n = 0; n < 2; ++n) *(f32x4*)(rowp + bj * HALF + n * 16) = acc[ai][bj][m][n] * scale; }
    }
};

struct EpiSoftmax {
    static constexpr bool PERM = true;
    bf16_t* O; size_t ldc; float scale; LAS unsigned char* xl;
    __device__ __forceinline__ void operator()(f32x4 (&acc)[2][2][4][2], const Unit& u, int wr, int wc, int fr, int fq) const {
        LAS f32x2* X = (LAS f32x2*)xl;
        float mown[2][4];
#pragma unroll
        for (int ai = 0; ai < 2; ++ai)
#pragma unroll
            for (int m = 0; m < 4; ++m) {
                float mx = -INFINITY;
#pragma unroll
                for (int bj = 0; bj < 2; ++bj)
#pragma unroll
                    for (int n = 0; n < 2; ++n) { const f32x4 v = acc[ai][bj][m][n]; mx = fmaxf(mx, fmaxf(fmaxf(v[0], v[1]), fmaxf(v[2], v[3]))); }
                mx = fmaxf(mx, __shfl_xor(mx, 16)); mx = fmaxf(mx, __shfl_xor(mx, 32));
                const float ms = mx * scale; float l = 0.f;
#pragma unroll
                for (int bj = 0; bj < 2; ++bj)
#pragma unroll
                    for (int n = 0; n < 2; ++n) { f32x4 v = acc[ai][bj][m][n];
#pragma unroll
                        for (int i = 0; i < 4; ++i) { v[i] = __builtin_amdgcn_exp2f(v[i] * scale - ms); l += v[i]; }
                        acc[ai][bj][m][n] = v; }
                l += __shfl_xor(l, 16); l += __shfl_xor(l, 32);
                mown[ai][m] = ms;
                if (fq == 0) X[(ai * HALF + wr * 64 + m * 16 + fr) * 4 + wc] = (f32x2){ms, l};
            }
        asm volatile("s_waitcnt lgkmcnt(0)" ::: "memory"); __builtin_amdgcn_s_barrier(); asm volatile("" ::: "memory");
        bf16_t* base = O + u.coff + (size_t)(wr * 64 + fr) * ldc + wc * 32 + 8 * fq;
#pragma unroll
        for (int ai = 0; ai < 2; ++ai)
#pragma unroll
            for (int m = 0; m < 4; ++m) {
                const LAS f32x4* xr = (const LAS f32x4*)(X + (ai * HALF + wr * 64 + m * 16 + fr) * 4);
                const f32x4 a = xr[0], b = xr[1];
                const float M = fmaxf(fmaxf(a[0], a[2]), fmaxf(b[0], b[2]));
                const float L = (a[1] * __builtin_amdgcn_exp2f(a[0] - M) + a[3] * __builtin_amdgcn_exp2f(a[2] - M)) + (b[1] * __builtin_amdgcn_exp2f(b[0] - M) + b[3] * __builtin_amdgcn_exp2f(b[2] - M));
                const float f = __builtin_amdgcn_exp2f(mown[ai][m] - M) / L;
                bf16_t* rowp = base + (size_t)(ai * HALF + m * 16) * ldc;
#pragma unroll
                for (int bj = 0; bj < 2; ++bj) { const f32x4 v0 = acc[ai][bj][m][0] * f, v1 = acc[ai][bj][m][1] * f;
                    u32x4 w; w.x = pk2(v0[0], v0[1]); w.y = pk2(v0[2], v0[3]); w.z = pk2(v1[0], v1[1]); w.w = pk2(v1[2], v1[3]);
                    *(u32x4*)(rowp + bj * HALF) = w; }
            }
        asm volatile("s_waitcnt lgkmcnt(0)" ::: "memory"); __builtin_amdgcn_s_barrier(); asm volatile("" ::: "memory");
    }
};

template <bool HIN_BF, bool HOUT_BF, bool NEXT> struct EpiResid {
    static constexpr bool PERM = true;
    const void* hres; void* hout; const float* gpost; float* rstd_out; float* xs; unsigned* cnt; LAS unsigned char* xl;
    __device__ __forceinline__ void stats(const float (&part)[2][4], const Unit& u, int bank, int wr, int wc, int fr, int fq) const {
        LAS float* P = (LAS float*)xl;
        LAS float* S = (LAS float*)(xl + 4096);
        const int wid = wr * 4 + wc, lane = fq * 16 + fr;
#pragma unroll
        for (int ai = 0; ai < 2; ++ai)
#pragma unroll
            for (int m = 0; m < 4; ++m) { float v = part[ai][m]; v += __shfl_xor(v, 16); v += __shfl_xor(v, 32); if (fq == 0) P[(ai * HALF + wr * 64 + m * 16 + fr) * 4 + wc] = v; }
        asm volatile("s_waitcnt lgkmcnt(0)" ::: "memory"); __builtin_amdgcn_s_barrier(); asm volatile("" ::: "memory");
        const int row = wid * 32 + (lane & 31);
        unsigned* slot = (unsigned*)(xs + ((size_t)bank * MTOK + (size_t)u.pm * BM + row) * 4);
        if (lane < 32) { const f32x4 p = *(const LAS f32x4*)(P + row * 4); const float t = (p[0] + p[1]) + (p[2] + p[3]);
            __hip_atomic_store(slot + u.pn, __float_as_uint(t), __ATOMIC_RELAXED, __HIP_MEMORY_SCOPE_AGENT); }
        asm volatile("s_waitcnt vmcnt(0)" ::: "memory");
        unsigned* c = cnt + ((size_t)bank * 256 + u.pm) * 64;
        if (lane == 0) __hip_atomic_fetch_add(c, 1u, __ATOMIC_RELAXED, __HIP_MEMORY_SCOPE_AGENT);
        if (wid == 0) {
            for (unsigned sp = 0; sp < (1u << 17); ++sp) { if ((unsigned)__builtin_amdgcn_readfirstlane(__hip_atomic_load(c, __ATOMIC_RELAXED, __HIP_MEMORY_SCOPE_AGENT)) >= 32u) break; __builtin_amdgcn_s_sleep(2); }
        }
        asm volatile("s_waitcnt vmcnt(0) lgkmcnt(0)" ::: "memory"); __builtin_amdgcn_s_barrier(); asm volatile("" ::: "memory");
        if (lane < 32) { float tot = 0.f;
#pragma unroll
            for (int t = 0; t < 4; ++t) tot += __uint_as_float(__hip_atomic_load(slot + t, __ATOMIC_RELAXED, __HIP_MEMORY_SCOPE_AGENT));
            S[row] = 1.0f / sqrtf(tot * (1.f / 1024.f) + RMS_EPS); }
        asm volatile("s_waitcnt lgkmcnt(0)" ::: "memory"); __builtin_amdgcn_s_barrier(); asm volatile("" ::: "memory");
    }
    __device__ __forceinline__ void operator()(f32x4 (&acc)[2][2][4][2], const Unit& u, int wr, int wc, int fr, int fq) const {
        const LAS float* S = (const LAS float*)(xl + 4096);
        float part[2][4];
#pragma unroll
        for (int ai = 0; ai < 2; ++ai)
#pragma unroll
            for (int m = 0; m < 4; ++m) { float sq = 0.f;
#pragma unroll
                for (int bj = 0; bj < 2; ++bj)
#pragma unroll
                    for (int n = 0; n < 2; ++n) { const f32x4 v = acc[ai][bj][m][n]; sq += (v[0] * v[0] + v[1] * v[1]) + (v[2] * v[2] + v[3] * v[3]); }
                part[ai][m] = sq; }
        const int col0 = u.pn * BM + wc * 32 + 8 * fq;
        constexpr int NPRE = HIN_BF ? 4 : 2;
        f32x4 pre[NPRE][2][2];
#pragma unroll
        for (int m = 0; m < NPRE; ++m) { const size_t off = (size_t)(u.pm * BM + wr * 64 + m * 16 + fr) * 1024 + col0;
#pragma unroll
            for (int bj = 0; bj < 2; ++bj) {
                if (HIN_BF) { const u32x4 w = *(const u32x4*)((const bf16_t*)hres + off + bj * HALF); pre[m][bj][0] = __builtin_bit_cast(f32x4, w); }
                else { pre[m][bj][0] = *(const f32x4*)((const float*)hres + off + bj * HALF); pre[m][bj][1] = *(const f32x4*)((const float*)hres + off + bj * HALF + 4); } } }
        stats(part, u, 0, wr, wc, fr, fq);
        f32x4 g[2][2];
#pragma unroll
        for (int bj = 0; bj < 2; ++bj) { g[bj][0] = *(const f32x4*)(gpost + col0 + bj * HALF); g[bj][1] = *(const f32x4*)(gpost + col0 + bj * HALF + 4); }
#pragma unroll
        for (int ai = 0; ai < 2; ++ai)
#pragma unroll
            for (int m = 0; m < 4; ++m) { const int rl = ai * HALF + wr * 64 + m * 16 + fr; const float rs = S[rl]; const size_t off = (size_t)(u.pm * BM + rl) * 1024 + col0; float sq = 0.f;
#pragma unroll
                for (int bj = 0; bj < 2; ++bj) { f32x4 h0, h1;
                    if (HIN_BF) { u32x4 w; if (ai == 0 && m < NPRE) w = __builtin_bit_cast(u32x4, pre[m < NPRE ? m : 0][bj][0]); else w = *(const u32x4*)((const bf16_t*)hres + off + bj * HALF);
                        h0 = (f32x4){bf_lo(w.x), bf_hi(w.x), bf_lo(w.y), bf_hi(w.y)}; h1 = (f32x4){bf_lo(w.z), bf_hi(w.z), bf_lo(w.w), bf_hi(w.w)}; }
                    else { if (ai == 0 && m < NPRE) { h0 = pre[m < NPRE ? m : 0][bj][0]; h1 = pre[m < NPRE ? m : 0][bj][1]; } else { h0 = *(const f32x4*)((const float*)hres + off + bj * HALF); h1 = *(const f32x4*)((const float*)hres + off + bj * HALF + 4); } }
                    h0 += acc[ai][bj][m][0] * rs * g[bj][0]; h1 += acc[ai][bj][m][1] * rs * g[bj][1];
                    if (HOUT_BF) { u32x4 w; w.x = pk2(h0[0], h0[1]); w.y = pk2(h0[2], h0[3]); w.z = pk2(h1[0], h1[1]); w.w = pk2(h1[2], h1[3]); *(u32x4*)((bf16_t*)hout + off + bj * HALF) = w; }
                    else { *(f32x4*)((float*)hout + off + bj * HALF) = h0; *(f32x4*)((float*)hout + off + bj * HALF + 4) = h1; }
                    if (NEXT) sq += ((h0[0] * h0[0] + h0[1] * h0[1]) + (h0[2] * h0[2] + h0[3] * h0[3])) + ((h1[0] * h1[0] + h1[1] * h1[1]) + (h1[2] * h1[2] + h1[3] * h1[3])); }
                part[ai][m] = sq; }
        if (NEXT) {
            stats(part, u, 1, wr, wc, fr, fq);
            if (u.pn == 0 && wc == 0 && fq == 0) {
#pragma unroll
                for (int ai = 0; ai < 2; ++ai)
#pragma unroll
                    for (int m = 0; m < 4; ++m) { const int rl = ai * HALF + wr * 64 + m * 16 + fr; rstd_out[u.pm * BM + rl] = S[rl]; }
            }
            asm volatile("s_waitcnt lgkmcnt(0)" ::: "memory"); __builtin_amdgcn_s_barrier(); asm volatile("" ::: "memory");
        }
    }
};

template <class Epi, class Sched>
__device__ __forceinline__ void gemm_phase(LAS unsigned char* lds, const Gemm g, const Sched& S, const Epi& E, const int tid) {
    const int wid = __builtin_amdgcn_readfirstlane(tid >> 6), lane = tid & 63, wr = wid >> 2, wc = wid & 3, fr = lane & 15, fq = lane >> 4;
    const int K = g.K, nt = K / BK;
    unsigned voffA[2], voffB[2];
#pragma unroll
    for (int i = 0; i < 2; ++i) { int R, C; stage_rc(tid * 16 + i * 8192, R, C); const int Rb = Epi::PERM ? ((R & ~31) + perm32(R & 31)) : R;
        voffA[i] = (unsigned)(R * g.lda + C) * 2u; voffB[i] = (unsigned)(Rb * g.ldb + C) * 2u; }
    const size_t kstepA = g.kstepA, kstepB = g.kstepB;
    const size_t hstepA = (size_t)HALF * g.lda * 2, hstepB = (size_t)HALF * g.ldb * 2;
    const unsigned ldsw = (unsigned)wid * 1024u;
    const int aoff = lds_byte(wr * 64 + fr, fq * 8), boff = lds_byte(wc * 32 + fr, fq * 8);
#define PG8_SA(b, h) (((b) * 2 + (h)) * HTB)
#define PG8_SB(b, h) ((4 + (b) * 2 + (h)) * HTB)
#define PG8_STAGE(bufoff, gbase, voff) do { _Pragma("unroll") for (int _i = 0; _i < 2; ++_i) \
        __builtin_amdgcn_global_load_lds((const unsigned*)((const char*)(gbase) + (voff)[_i]), (LAS unsigned*)(lds + (bufoff) + ldsw + _i * 8192), 16, 0, 0); } while (0)
#define PG8_LDA(dst, b, h) do { _Pragma("unroll") for (int m = 0; m < 4; ++m) _Pragma("unroll") for (int k = 0; k < 2; ++k) dst[m][k] = *(const LAS bf16x8*)(lds + PG8_SA(b, h) + aoff + m * 2048 + k * 1024); } while (0)
#define PG8_LDB(dst, b, h) do { _Pragma("unroll") for (int n = 0; n < 2; ++n) _Pragma("unroll") for (int k = 0; k < 2; ++k) dst[n][k] = *(const LAS bf16x8*)(lds + PG8_SB(b, h) + boff + n * 2048 + k * 1024); } while (0)
#define PG8_MMA(ai, bj, At, Bt) do { __builtin_amdgcn_s_setprio(1); _Pragma("unroll") for (int m = 0; m < 4; ++m) _Pragma("unroll") for (int n = 0; n < 2; ++n) _Pragma("unroll") for (int k = 0; k < 2; ++k) \
        acc[ai][bj][m][n] = __builtin_amdgcn_mfma_f32_16x16x32_bf16(Bt[n][k], At[m][k], acc[ai][bj][m][n], 0, 0, 0); __builtin_amdgcn_s_setprio(0); } while (0)
#define PG8_WAIT_V(n) asm volatile("s_waitcnt vmcnt(" #n ")" ::: "memory")
#define PG8_WAIT_L(n) asm volatile("s_waitcnt lgkmcnt(" #n ")" ::: "memory")
#define PG8_BAR __builtin_amdgcn_s_barrier()
#define PG8_SCHED __builtin_amdgcn_sched_barrier(0)
    Unit cur, nxt; int ui = 0;
    if (!S.next(0, cur)) return;
    f32x4 acc[2][2][4][2];
#pragma unroll
    for (int a = 0; a < 2; ++a)
#pragma unroll
        for (int b = 0; b < 2; ++b)
#pragma unroll
            for (int m = 0; m < 4; ++m)
#pragma unroll
                for (int n = 0; n < 2; ++n) acc[a][b][m][n] = (f32x4){0.f, 0.f, 0.f, 0.f};
    bf16x8 At[4][2], B0[2][2], B1[2][2];
    const char* cA = g.A + cur.aoff; const char* cB = g.Bt + cur.boff;
    PG8_STAGE(PG8_SB(0, 0), cB, voffB); PG8_STAGE(PG8_SB(0, 1), cB + hstepB, voffB); PG8_STAGE(PG8_SA(0, 0), cA, voffA); PG8_STAGE(PG8_SA(0, 1), cA + hstepA, voffA);
    if (wr == 1) PG8_BAR;
    PG8_WAIT_V(2); PG8_BAR;
    PG8_STAGE(PG8_SB(1, 0), cB + kstepB, voffB); PG8_STAGE(PG8_SA(1, 0), cA + kstepA, voffA); PG8_STAGE(PG8_SB(1, 1), cB + hstepB + kstepB, voffB);
    PG8_WAIT_V(6); PG8_BAR;
    for (;;) {
        const bool has_next = S.next(ui + 1, nxt);
        const char* nA = has_next ? g.A + nxt.aoff : cA; const char* nB = has_next ? g.Bt + nxt.boff : cB;
        for (int t = 0; t < nt; t += 2) {
            const bool last = (t == nt - 2);
            const char* a1 = cA + (size_t)(t + 1) * kstepA;
            const char* a2 = last ? nA : cA + (size_t)(t + 2) * kstepA; const char* b2 = last ? nB : cB + (size_t)(t + 2) * kstepB;
            const char* a3 = a2 + kstepA; const char* b3 = b2 + kstepB;
            PG8_LDB(B0, 0, 0); PG8_LDB(B1, 0, 1); PG8_SCHED; PG8_LDA(At, 0, 0); PG8_STAGE(PG8_SA(1, 1), a1 + hstepA, voffA);
            PG8_WAIT_V(8); PG8_WAIT_L(0); PG8_BAR; PG8_MMA(0, 0, At, B0); PG8_MMA(0, 1, At, B1); PG8_BAR; PG8_SCHED;
            PG8_LDA(At, 0, 1); PG8_STAGE(PG8_SB(0, 0), b2, voffB); PG8_STAGE(PG8_SB(0, 1), b2 + hstepB, voffB); PG8_STAGE(PG8_SA(0, 0), a2, voffA);
            PG8_WAIT_V(8); PG8_WAIT_L(0); PG8_BAR; PG8_MMA(1, 0, At, B0); PG8_MMA(1, 1, At, B1); PG8_BAR; PG8_SCHED;
            PG8_LDB(B0, 1, 0); PG8_LDB(B1, 1, 1); PG8_SCHED; PG8_LDA(At, 1, 0); PG8_STAGE(PG8_SA(0, 1), a2 + hstepA, voffA);
            PG8_WAIT_V(8); PG8_WAIT_L(0); PG8_BAR; PG8_MMA(0, 0, At, B0); PG8_MMA(0, 1, At, B1); PG8_BAR; PG8_SCHED;
            PG8_LDA(At, 1, 1); PG8_STAGE(PG8_SB(1, 0), b3, voffB); PG8_STAGE(PG8_SB(1, 1), b3 + hstepB, voffB); PG8_STAGE(PG8_SA(1, 0), a3, voffA);
            PG8_WAIT_V(8); PG8_WAIT_L(0); PG8_BAR; PG8_MMA(1, 0, At, B0); PG8_MMA(1, 1, At, B1); PG8_BAR; PG8_SCHED;
        }
        if (wr == 0) PG8_BAR;
        E(acc, cur, wr, wc, fr, fq);
        if (!has_next) break;
#pragma unroll
        for (int a = 0; a < 2; ++a)
#pragma unroll
            for (int b = 0; b < 2; ++b)
#pragma unroll
                for (int m = 0; m < 4; ++m)
#pragma unroll
                    for (int n = 0; n < 2; ++n) acc[a][b][m][n] = (f32x4){0.f, 0.f, 0.f, 0.f};
        cur = nxt; cA = nA; cB = nB; ++ui;
        if (wr == 1) PG8_BAR;
    }
    PG8_WAIT_V(0);
    PG8_BAR;
#undef PG8_SA
#undef PG8_SB
#undef PG8_STAGE
#undef PG8_LDA
#undef PG8_LDB
#undef PG8_MMA
#undef PG8_WAIT_V
#undef PG8_WAIT_L
#undef PG8_BAR
#undef PG8_SCHED
}
}

namespace att {
constexpr float LOG2E = 1.4426950408889634f;
constexpr float C2 = 0.125f * LOG2E;
constexpr float THR = 8.f;
constexpr int L_KV = 0;
constexpr int L_IMP = 32768;
constexpr int L_CK = 65536;
constexpr int L_WS = 66560;
constexpr int L_OST = 68608;
constexpr int L_ISUM = 134144;
constexpr int L_MASK = 142336;
constexpr int L_MISC = 142592;

struct KVSrc { const bf16_t* k; const bf16_t* v; int pitch; int nrows; };

__device__ __forceinline__ void glds16(const void* gsrc, unsigned lds_dst) { unsigned keep;
    asm volatile("s_mov_b32 %0, m0\n\ts_mov_b32 m0, %2\n\ts_nop 0\n\tglobal_load_lds_dwordx4 %1, off\n\ts_mov_b32 m0, %0" : "=&s"(keep) : "v"(gsrc), "s"(lds_dst) : "memory"); }
__device__ __forceinline__ void glds4(const void* gsrc, unsigned lds_dst) { unsigned keep;
    asm volatile("s_mov_b32 %0, m0\n\ts_mov_b32 m0, %2\n\ts_nop 0\n\tglobal_load_lds_dword %1, off\n\ts_mov_b32 m0, %0" : "=&s"(keep) : "v"(gsrc), "s"(lds_dst) : "memory"); }
#define WAIT_BAR(N) asm volatile("s_waitcnt vmcnt(" #N ") lgkmcnt(0)\n\ts_barrier" ::: "memory")
__device__ __forceinline__ void dma_tile(LAS unsigned char* lds, int stage, const KVSrc& s, int key0, int wid, int lane) {
    const unsigned base = (unsigned)(unsigned long long)(lds + L_KV) + (unsigned)(stage * 16384 + wid * 1024);
    int kr = key0 + lane; kr = kr < 0 ? 0 : (kr >= s.nrows ? s.nrows - 1 : kr);
    const bf16_t* ks = s.k + (size_t)kr * s.pitch + wid * 8;
    glds16(ks, (unsigned)__builtin_amdgcn_readfirstlane(base));
    int vr = key0 + 16 * (wid & 3) + (lane >> 2); vr = vr < 0 ? 0 : (vr >= s.nrows ? s.nrows - 1 : vr);
    const bf16_t* vs = s.v + (size_t)vr * s.pitch + (wid >> 2) * 32 + (lane & 3) * 8;
    glds16(vs, (unsigned)__builtin_amdgcn_readfirstlane(base + 8192u));
}

__device__ __forceinline__ void qkt(f32x16& p0, f32x16& p1, const LAS unsigned char* Kslot, const bf16x8 (&qr)[4], const f32x16& c0, const f32x16& c1, int r32, int hi) {
    const LAS unsigned char* kb = Kslot + hi * 1024 + r32 * 16;
    f32x16 a, b;
    { const bf16x8 b0 = *(const LAS bf16x8*)(kb), b1 = *(const LAS bf16x8*)(kb + 512);
      a = __builtin_amdgcn_mfma_f32_32x32x16_bf16(b0, qr[0], c0, 0, 0, 0); b = __builtin_amdgcn_mfma_f32_32x32x16_bf16(b1, qr[0], c1, 0, 0, 0); }
#pragma unroll
    for (int d0 = 1; d0 < 4; ++d0) {
        const bf16x8 b0 = *(const LAS bf16x8*)(kb + d0 * 2048);
        const bf16x8 b1 = *(const LAS bf16x8*)(kb + d0 * 2048 + 512);
        a = __builtin_amdgcn_mfma_f32_32x32x16_bf16(b0, qr[d0], a, 0, 0, 0);
        b = __builtin_amdgcn_mfma_f32_32x32x16_bf16(b1, qr[d0], b, 0, 0, 0);
    }
    p0 = a; p1 = b;
}
typedef short v4i16_t __attribute__((ext_vector_type(4)));
__device__ __forceinline__ s16x4 vtr(const LAS unsigned char* p) { return __builtin_bit_cast(s16x4, __builtin_amdgcn_ds_read_tr16_b64_v4i16((LAS v4i16_t*)p)); }
__device__ __forceinline__ void pv(f32x16 (&o)[2], f32x16& lacc, const LAS unsigned char* Vslot, const bf16x8 (&pa)[4], int lane, int hi) {
    const LAS unsigned char* vp = Vslot + ((lane >> 4) & 1) * 32 + (lane & 3) * 8 + (4 * hi + ((lane & 15) >> 2)) * 64;
    const bf16x8 ones = {16256, 16256, 16256, 16256, 16256, 16256, 16256, 16256};
#pragma unroll
    for (int ks = 0; ks < 4; ++ks) {
#pragma unroll
        for (int d0 = 0; d0 < 2; ++d0) {
            const s16x4 lo = vtr(vp + d0 * 4096 + ks * 1024), hh = vtr(vp + d0 * 4096 + ks * 1024 + 512);
            const bf16x8 vf = {lo[0], lo[1], lo[2], lo[3], hh[0], hh[1], hh[2], hh[3]};
            o[d0] = __builtin_amdgcn_mfma_f32_32x32x16_bf16(pa[ks], vf, o[d0], 0, 0, 0);
        }
        lacc = __builtin_amdgcn_mfma_f32_32x32x16_bf16(pa[ks], ones, lacc, 0, 0, 0);
    }
}
__device__ __forceinline__ bf16x8 pack8(const f32x16& p, int b) {
    u32x4 w; w.x = pk2(p[b], p[b + 1]); w.y = pk2(p[b + 2], p[b + 3]); w.z = pk2(p[b + 4], p[b + 5]); w.w = pk2(p[b + 6], p[b + 7]);
    return __builtin_bit_cast(bf16x8, w);
}
__device__ __forceinline__ float max3f(float a, float b, float c) { float r; asm("v_max3_f32 %0, %1, %2, %3" : "=v"(r) : "v"(a), "v"(b), "v"(c)); return r; }
__device__ __forceinline__ float max2f(float a, float b) { float r; asm("v_max_f32_e32 %0, %1, %2" : "=v"(r) : "v"(a), "v"(b)); return r; }
__device__ __forceinline__ float rowmax(const f32x16& p0, const f32x16& p1) {
    float a = max3f(p0[0], p0[1], p1[0]), b = max3f(p0[2], p0[3], p1[1]); a = max3f(a, p1[2], p1[3]);
#pragma unroll
    for (int r = 4; r < 16; r += 4) { a = max3f(a, p0[r], p0[r + 1]); b = max3f(b, p0[r + 2], p0[r + 3]); a = max3f(a, p1[r], p1[r + 1]); b = max3f(b, p1[r + 2], p1[r + 3]); }
    const float m = max2f(a, b);
    return max2f(m, __shfl_xor(m, 32));
}
__device__ __forceinline__ void load_rowfac(f32x4 (&a)[4], LAS float* ws, float f, int r32, int hi) {
    asm volatile("" ::: "memory");
    if (hi == 0) ws[r32] = f;
    asm volatile("s_waitcnt lgkmcnt(0)" ::: "memory");
#pragma unroll
    for (int k4 = 0; k4 < 4; ++k4) a[k4] = *(const LAS f32x4*)(ws + 8 * k4 + 4 * hi);
    asm volatile("s_waitcnt lgkmcnt(0)" ::: "memory");
}

template <int MODE>
__device__ __forceinline__ void flash_sweep(LAS unsigned char* lds, const KVSrc& src, const bf16x8 (&qr)[4], f32x16 (&o)[2], f32x16& lacc,
                                            unsigned tiles, int qpos, int wq_min, int wq_max, unsigned rowmask, const float* ck2, float cq2,
                                            int wid, int lane) {
    const int r32 = lane & 31, hi = lane >> 5;
    LAS float* ws = (LAS float*)(lds + L_WS + wid * 256);
    f32x16 negm;
#pragma unroll
    for (int r = 0; r < 16; ++r) { o[0][r] = 0.f; o[1][r] = 0.f; lacc[r] = 0.f; negm[r] = 0.f; }
    float mhat = 0.f; bool fresh = true;
    unsigned ri = tiles, rc = tiles; int issued = 0, it = 0;
    const unsigned ckbase = (unsigned)(unsigned long long)(lds + L_CK);
#pragma unroll 1
    for (int k = 0; k < 3 && ri; ++k) { const int jn = __builtin_ctz(ri); ri &= ri - 1; dma_tile(lds, issued & 3, src, 64 * jn, wid, lane);
        if (MODE == 0 && wid == 0) glds4(ck2 + 64 * jn + lane, (unsigned)__builtin_amdgcn_readfirstlane(ckbase + (issued & 3) * 256)); ++issued; }
#pragma unroll 1
    while (rc) {
        const int j = __builtin_ctz(rc); rc &= rc - 1;
        const int ahead = issued - it - 1, st = it & 3;
        if (MODE == 0 && wid == 0) { if (ahead >= 2) WAIT_BAR(6); else if (ahead == 1) WAIT_BAR(3); else WAIT_BAR(0); }
        else { if (ahead >= 2) WAIT_BAR(4); else if (ahead == 1) WAIT_BAR(2); else WAIT_BAR(0); }
        if (ri) { const int jn = __builtin_ctz(ri); ri &= ri - 1; dma_tile(lds, issued & 3, src, 64 * jn, wid, lane);
            if (MODE == 0 && wid == 0) glds4(ck2 + 64 * jn + lane, (unsigned)__builtin_amdgcn_readfirstlane(ckbase + (issued & 3) * 256)); ++issued; }
        ++it;
        const int k0 = 64 * j;
        const bool skip = (k0 > wq_max) || (MODE == 2 && k0 + 63 <= wq_min - 512);
        if (!skip) {
            const LAS unsigned char* Ks = lds + L_KV + st * 16384;
            f32x16 p0, p1;
            if (MODE == 0) {
                const LAS float* ckp = (const LAS float*)(lds + L_CK + st * 256);
                const float base = cq2 - mhat; f32x16 c0v, c1v;
#pragma unroll
                for (int k4 = 0; k4 < 4; ++k4) { const f32x4 c0 = *(const LAS f32x4*)(ckp + 8 * k4 + 4 * hi), c1 = *(const LAS f32x4*)(ckp + 32 + 8 * k4 + 4 * hi);
#pragma unroll
                    for (int i = 0; i < 4; ++i) { c0v[4 * k4 + i] = base - c0[i]; c1v[4 * k4 + i] = base - c1[i]; } }
                qkt(p0, p1, Ks, qr, c0v, c1v, r32, hi);
            } else qkt(p0, p1, Ks, qr, negm, negm, r32, hi);
            const int qrel = qpos - k0 - 4 * hi;
            if (k0 + 63 > wq_min) {
                asm volatile("" ::: "memory");
#pragma unroll
                for (int r = 0; r < 16; ++r) { const int c = (r & 3) + 8 * (r >> 2); if (c > qrel) p0[r] = -INFINITY; if (c + 32 > qrel) p1[r] = -INFINITY; }
            }
            if (MODE == 2 && k0 <= wq_max - 512) {
                asm volatile("" ::: "memory");
#pragma unroll
                for (int r = 0; r < 16; ++r) { const int c = (r & 3) + 8 * (r >> 2); if (c <= qrel - 512) p0[r] = -INFINITY; if (c + 32 <= qrel - 512) p1[r] = -INFINITY; }
            }
            if (MODE == 1) {
                if (!__all((rowmask >> j) & 1u)) {
                    asm volatile("" ::: "memory");
                    const bool dead = !((rowmask >> j) & 1u);
#pragma unroll
                    for (int r = 0; r < 16; ++r) { if (dead) { p0[r] = -INFINITY; p1[r] = -INFINITY; } }
                }
            }
            const float rm = rowmax(p0, p1);
            const bool need = fresh ? (rm > -INFINITY) : (rm > THR);
            if (__any(need)) {
                asm volatile("" ::: "memory");
                const float dl = need ? (fresh ? rm : fmaxf(rm, 0.f)) : 0.f;
                const float alpha = fresh ? 1.f : __builtin_amdgcn_exp2f(-dl);
                mhat += dl; fresh = fresh && !need;
#pragma unroll
                for (int r = 0; r < 16; ++r) { p0[r] -= dl; p1[r] -= dl; negm[r] = -mhat; }
                f32x4 a[4]; load_rowfac(a, ws, alpha, r32, hi);
#pragma unroll
                for (int k4 = 0; k4 < 4; ++k4)
#pragma unroll
                    for (int i = 0; i < 4; ++i) { o[0][4 * k4 + i] *= a[k4][i]; o[1][4 * k4 + i] *= a[k4][i]; lacc[4 * k4 + i] *= a[k4][i]; }
            }
#pragma unroll
            for (int r = 0; r < 16; ++r) { p0[r] = __builtin_amdgcn_exp2f(p0[r]); p1[r] = __builtin_amdgcn_exp2f(p1[r]); }
            bf16x8 pa[4]; pa[0] = pack8(p0, 0); pa[1] = pack8(p0, 8); pa[2] = pack8(p1, 0); pa[3] = pack8(p1, 8);
            pv(o, lacc, Ks + 8192, pa, lane, hi);
        }
    }
    WAIT_BAR(0);
}

__device__ __forceinline__ void store_o(LAS unsigned char* lds, const f32x16 (&o)[2], const f32x16& fac, bf16_t* Ow, size_t pitch, int wid, int lane) {
    const int r32 = lane & 31, hi = lane >> 5;
    LAS bf16_t* stg = (LAS bf16_t*)(lds + L_OST + wid * 4096);
#pragma unroll
    for (int r = 0; r < 16; ++r) { const int orow = (r & 3) + 8 * (r >> 2) + 4 * hi;
#pragma unroll
        for (int d0 = 0; d0 < 2; ++d0) { const unsigned w = pk2(o[d0][r] * fac[r], 0.f); stg[orow * 64 + d0 * 32 + r32] = (bf16_t)(w & 0xffffu); } }
    asm volatile("s_waitcnt lgkmcnt(0)" ::: "memory");
#pragma unroll
    for (int i = 0; i < 4; ++i) { const int row = i * 8 + (lane >> 3), ch = lane & 7; const u32x4 v = *(const LAS u32x4*)(stg + row * 64 + ch * 8); *(u32x4*)(Ow + (size_t)row * pitch + ch * 8) = v; }
    asm volatile("s_waitcnt lgkmcnt(0)" ::: "memory");
}


template <bool FIRST>
__device__ __forceinline__ void acc_tile(LAS float* tl, const f32x16 (&o)[2], const f32x16& fac, int r32, int hi) {
#pragma unroll
    for (int r = 0; r < 16; ++r) { const int orow = (r & 3) + 8 * (r >> 2) + 4 * hi; const float f = fac[r];
#pragma unroll
        for (int d0 = 0; d0 < 2; ++d0) { LAS float* p = tl + orow * 64 + d0 * 32 + r32; if (FIRST) *p = o[d0][r] * f; else *p += o[d0][r] * f; } }
}
__device__ __forceinline__ void store_tile(const LAS float* tl, bf16_t* Ow, size_t pitch, int lane) {
    asm volatile("s_waitcnt lgkmcnt(0)" ::: "memory");
#pragma unroll
    for (int i = 0; i < 4; ++i) { const int row = i * 8 + (lane >> 3), ch = lane & 7; const f32x4 v0 = *(const LAS f32x4*)(tl + row * 64 + ch * 8), v1 = *(const LAS f32x4*)(tl + row * 64 + ch * 8 + 4);
        u32x4 w; w.x = pk2(v0[0], v0[1]); w.y = pk2(v0[2], v0[3]); w.z = pk2(v1[0], v1[1]); w.w = pk2(v1[2], v1[3]); *(u32x4*)(Ow + (size_t)row * pitch + ch * 8) = w; }
    asm volatile("s_waitcnt lgkmcnt(0)" ::: "memory");
}

__device__ __forceinline__ bf16x8 scale_q(bf16x8 q) {
    const u32x4 w = __builtin_bit_cast(u32x4, q); u32x4 o;
#pragma unroll
    for (int i = 0; i < 4; ++i) o[i] = pk2(bf_lo(w[i]) * C2, bf_hi(w[i]) * C2);
    return __builtin_bit_cast(bf16x8, o);
}
__device__ __forceinline__ void fox_unit(LAS unsigned char* lds, int b, int h, int qb, const bf16_t* PROJ, const float* C2buf, const float* nrm, bf16_t* AO, int wid, int lane) {
    const int r32 = lane & 31, hi = lane >> 5;
    const size_t rowbase = (size_t)b * SEQ;
    const int q0 = qb * 256 + wid * 32, qpos = q0 + r32;
    const bf16_t* Qp = PROJ + (rowbase + qpos) * NPROJ + C_FQ + h * 64;
    bf16x8 qr[4];
#pragma unroll
    for (int d0 = 0; d0 < 4; ++d0) qr[d0] = scale_q(*(const bf16x8*)(Qp + d0 * 16 + hi * 8));
    const float* ck2 = C2buf + ((size_t)b * 8 + h) * SEQ;
    float cq2 = ck2[qpos];
    asm volatile("" : "+v"(qr[0]), "+v"(qr[1]), "+v"(qr[2]), "+v"(qr[3]), "+v"(cq2));
    KVSrc src{PROJ + rowbase * NPROJ + C_FK + h * 64, PROJ + rowbase * NPROJ + C_FV + h * 64, NPROJ, SEQ};
    const int nt = 4 * qb + 4;
    unsigned tiles = nt >= 32 ? 0xffffffffu : ((1u << nt) - 1u);
    {
        const float smax = C2 * sqrtf(nrm[0]) * sqrtf(nrm[1]) * 1.01f + 0.01f;
        const int kt = lane < 32 ? lane : 31; const float dec = ck2[64 * kt + 63] - ck2[qb * 256];
        const unsigned keep = (unsigned)__ballot(dec <= 2.f * smax + 40.f);
        tiles &= keep | (0xfu << (4 * qb));
    }
    f32x16 o[2], lacc;
    flash_sweep<0>(lds, src, qr, o, lacc, tiles, qpos, q0, q0 + 31, 0u, ck2, cq2, wid, lane);
#pragma unroll
    for (int r = 0; r < 16; ++r) lacc[r] = __builtin_amdgcn_rcpf(lacc[r]);
    store_o(lds, o, lacc, AO + (rowbase + q0) * DM + h * 64, DM, wid, lane);
}

__device__ __forceinline__ void nsa_unit(LAS unsigned char* lds, int b, int g, int pb, const bf16_t* PROJ, const bf16_t* KC, const float* FG, const f32x2* ROPE, bf16_t* AO, int wid, int lane) {
    const int tid = wid * 64 + lane, r32 = lane & 31, hi = lane >> 5;
    const int hr = wid & 3, ph = wid >> 2, hd = 4 * g + hr;
    const size_t rowbase = (size_t)b * SEQ;
    const int q0 = pb * 64 + ph * 32, qpos = q0 + r32;
    LAS float* ws = (LAS float*)(lds + L_WS + wid * 256);
    const bf16_t* Qp = PROJ + (rowbase + qpos) * NPROJ + C_NQ + hd * 64;
    bf16x8 qr[4];
#pragma unroll
    for (int d0 = 0; d0 < 4; ++d0) qr[d0] = scale_q(*(const bf16x8*)(Qp + d0 * 16 + hi * 8));
    const float* gp = FG + (rowbase + qpos) * 32 + 8 + hd * 3;
    float g0 = 1.f / (1.f + __expf(-gp[0])), g1 = 1.f / (1.f + __expf(-gp[1])), g2 = 1.f / (1.f + __expf(-gp[2]));
    LAS float* tl = (LAS float*)(lds + L_OST + wid * 8192);
    {
        const bf16_t* kc = KC + ((size_t)(b * 2 + g) * 2 + 0) * 128 * 64; const bf16_t* vc = kc + 128 * 64;
        KVSrc csrc{kc, vc, 64, 128};
        dma_tile(lds, 0, csrc, 0, wid, lane); dma_tile(lds, 1, csrc, 64, wid, lane);
        WAIT_BAR(0);
        asm volatile("" : "+v"(qr[0]), "+v"(qr[1]), "+v"(qr[2]), "+v"(qr[3]), "+v"(g0), "+v"(g1), "+v"(g2));
        float m = -1e30f, l = 0.f; f32x16 zero16, lc;
#pragma unroll
        for (int r = 0; r < 16; ++r) { zero16[r] = 0.f; lc[r] = 0.f; }
        const int nthr = ((qpos - 31) >> 4) - 4 * hi;
#pragma unroll
        for (int ti = 0; ti < 2; ++ti) {
            f32x16 p0, p1; qkt(p0, p1, lds + L_KV + ti * 16384, qr, zero16, zero16, r32, hi);
            float rm = -INFINITY;
#pragma unroll
            for (int r = 0; r < 16; ++r) { const int n = 64 * ti + (r & 3) + 8 * (r >> 2);
                float v0 = p0[r], v1 = p1[r]; if (n > nthr) v0 = -INFINITY; if (n + 32 > nthr) v1 = -INFINITY;
                p0[r] = v0; p1[r] = v1; rm = fmaxf(rm, fmaxf(v0, v1)); }
            rm = fmaxf(rm, __shfl_xor(rm, 32));
            const float mn = fmaxf(m, rm); float ls = 0.f;
#pragma unroll
            for (int r = 0; r < 16; ++r) ls += __builtin_amdgcn_exp2f(p0[r] - mn) + __builtin_amdgcn_exp2f(p1[r] - mn);
            l = l * __builtin_amdgcn_exp2f(m - mn) + ls; m = mn;
        }
        l += __shfl_xor(l, 32);
        const float inv = l > 0.f ? 1.f / l : 0.f;
        f32x16 o[2];
#pragma unroll
        for (int r = 0; r < 16; ++r) { o[0][r] = 0.f; o[1][r] = 0.f; }
        LAS float* impw = (LAS float*)(lds + L_IMP) + ((size_t)hr * 64 + ph * 32 + r32) * 33;
        float carry = 0.f;
#pragma unroll
        for (int ti = 0; ti < 2; ++ti) {
            f32x16 p0, p1; qkt(p0, p1, lds + L_KV + ti * 16384, qr, zero16, zero16, r32, hi);
#pragma unroll
            for (int r = 0; r < 16; ++r) { const int n = 64 * ti + (r & 3) + 8 * (r >> 2);
                float v0 = p0[r], v1 = p1[r]; if (n > nthr) v0 = -INFINITY; if (n + 32 > nthr) v1 = -INFINITY;
                p0[r] = __builtin_amdgcn_exp2f(v0 - m) * inv; p1[r] = __builtin_amdgcn_exp2f(v1 - m) * inv; }
#pragma unroll
            for (int k = 0; k < 4; ++k) { const float G = (p0[4 * k] + p0[4 * k + 1]) + (p0[4 * k + 2] + p0[4 * k + 3]); const float pe = __shfl_xor(p0[4 * k + 3], 32);
                impw[8 * (2 * ti) + 2 * k + hi] = G + (hi ? pe : carry); carry = pe; }
#pragma unroll
            for (int k = 0; k < 4; ++k) { const float G = (p1[4 * k] + p1[4 * k + 1]) + (p1[4 * k + 2] + p1[4 * k + 3]); const float pe = __shfl_xor(p1[4 * k + 3], 32);
                impw[8 * (2 * ti + 1) + 2 * k + hi] = G + (hi ? pe : carry); carry = pe; }
            bf16x8 pa[4]; pa[0] = pack8(p0, 0); pa[1] = pack8(p0, 8); pa[2] = pack8(p1, 0); pa[3] = pack8(p1, 8);
            pv(o, lc, lds + L_KV + ti * 16384 + 8192, pa, lane, hi);
        }
        f32x4 a[4]; load_rowfac(a, ws, g0, r32, hi); f32x16 fac;
#pragma unroll
        for (int r = 0; r < 16; ++r) fac[r] = a[r >> 2][r & 3];
        acc_tile<true>(tl, o, fac, r32, hi);
    }
    f32x4 rcs[8];
    { const f32x4* rp4 = (const f32x4*)(ROPE + (size_t)qpos * 32);
#pragma unroll
      for (int d0 = 0; d0 < 4; ++d0) { rcs[2 * d0] = rp4[4 * d0 + 2 * hi]; rcs[2 * d0 + 1] = rp4[4 * d0 + 2 * hi + 1]; } }
    __syncthreads();
    {
        const int pos = tid >> 3, jq = tid & 7;
        const LAS float* ip = (const LAS float*)(lds + L_IMP) + (size_t)pos * 33 + 4 * jq;
        f32x4 v;
#pragma unroll
        for (int i = 0; i < 4; ++i) v[i] = ((ip[i] + ip[64 * 33 + i]) + ip[2 * 64 * 33 + i]) + ip[3 * 64 * 33 + i];
#pragma unroll
        for (int i = 0; i < 4; ++i) { const int jj = 4 * jq + i; float x = v[i];
            if (jj == pb) x = 2.0e4f; else if (jj == 0 || jj == pb - 1) x = 1.0e4f;
            if (jj > pb) x = -1.0f; v[i] = x; }
        *(LAS f32x4*)((LAS float*)(lds + L_ISUM) + (size_t)pos * 32 + 4 * jq) = v;
    }
    __syncthreads();
    {
        const int pos = tid >> 3, jq = tid & 7;
        const LAS float* sp = (const LAS float*)(lds + L_ISUM) + (size_t)pos * 32;
        const f32x4 mine = *(const LAS f32x4*)(sp + 4 * jq);
        int rk0 = 0, rk1 = 0, rk2 = 0, rk3 = 0; const int j0 = 4 * jq;
#pragma unroll 4
        for (int c = 0; c < 32; ++c) { const float a = sp[c];
            rk0 += (a > mine[0] || (a == mine[0] && c < j0)) ? 1 : 0; rk1 += (a > mine[1] || (a == mine[1] && c < j0 + 1)) ? 1 : 0;
            rk2 += (a > mine[2] || (a == mine[2] && c < j0 + 2)) ? 1 : 0; rk3 += (a > mine[3] || (a == mine[3] && c < j0 + 3)) ? 1 : 0; }
        unsigned bits = (rk0 < 16 ? 1u : 0u) | (rk1 < 16 ? 2u : 0u) | (rk2 < 16 ? 4u : 0u) | (rk3 < 16 ? 8u : 0u); bits <<= j0;
        bits |= __shfl_xor(bits, 1); bits |= __shfl_xor(bits, 2); bits |= __shfl_xor(bits, 4);
        if (jq == 0) ((LAS unsigned*)(lds + L_MASK))[pos] = bits;
    }
    __syncthreads();
    {
#pragma unroll
        for (int d0 = 0; d0 < 4; ++d0) {
            const u32x4 w = __builtin_bit_cast(u32x4, qr[d0]); u32x4 wo;
#pragma unroll
            for (int i = 0; i < 4; ++i) { const f32x4 c4 = rcs[2 * d0 + (i >> 1)]; const f32x2 cs = (i & 1) ? (f32x2){c4[2], c4[3]} : (f32x2){c4[0], c4[1]}; const float x1 = bf_lo(w[i]), x2 = bf_hi(w[i]);
                wo[i] = pk2(x1 * cs.x - x2 * cs.y, x2 * cs.x + x1 * cs.y); }
            qr[d0] = __builtin_bit_cast(bf16x8, wo);
        }
        asm volatile("" : "+v"(qr[0]), "+v"(qr[1]), "+v"(qr[2]), "+v"(qr[3]));
    }
    const unsigned upto = pb >= 31 ? 0xffffffffu : ((1u << (pb + 1)) - 1u);
#ifndef NO_SLC
    {
        const LAS unsigned* mk = (const LAS unsigned*)(lds + L_MASK);
        const unsigned rowmask = mk[ph * 32 + r32] & upto;
        unsigned un = mk[lane];
#pragma unroll
        for (int o_ = 1; o_ < 64; o_ <<= 1) un |= __shfl_xor(un, o_);
        un = (unsigned)__builtin_amdgcn_readfirstlane(un) & upto;
        KVSrc src{PROJ + rowbase * NPROJ + C_KS + g * 64, PROJ + rowbase * NPROJ + C_VS + g * 64, NPROJ, SEQ};
        f32x16 o[2], lacc;
        flash_sweep<1>(lds, src, qr, o, lacc, un, qpos, q0, q0 + 31, rowmask, nullptr, 0.f, wid, lane);
        f32x4 a[4]; load_rowfac(a, ws, g1, r32, hi);
#pragma unroll
        for (int r = 0; r < 16; ++r) lacc[r] = lacc[r] > 0.f ? a[r >> 2][r & 3] * __builtin_amdgcn_rcpf(lacc[r]) : 0.f;
        acc_tile<false>(tl, o, lacc, r32, hi);
    }
#endif
#ifndef NO_WIN
    {
        const int tlo = pb - 8 < 0 ? 0 : pb - 8;
        const unsigned tiles = upto & ~((1u << tlo) - 1u);
        KVSrc src{PROJ + rowbase * NPROJ + C_KW + g * 64, PROJ + rowbase * NPROJ + C_VW + g * 64, NPROJ, SEQ};
        f32x16 o[2], lacc;
        flash_sweep<2>(lds, src, qr, o, lacc, tiles, qpos, q0, q0 + 31, 0u, nullptr, 0.f, wid, lane);
        f32x4 a[4]; load_rowfac(a, ws, g2, r32, hi);
#pragma unroll
        for (int r = 0; r < 16; ++r) lacc[r] = lacc[r] > 0.f ? a[r >> 2][r & 3] * __builtin_amdgcn_rcpf(lacc[r]) : 0.f;
        acc_tile<false>(tl, o, lacc, r32, hi);
    }
#endif
    store_tile(tl, AO + (rowbase + q0) * DM + 512 + hd * 64, DM, lane);
}
}

constexpr int NWAVES = 8;
constexpr int LDS_BYTES = 147456;
constexpr int NPHASE = 16;

struct Args {
    const float* in[23]; float* out; unsigned char* ws; int ph_lo, ph_hi;
};

__device__ __forceinline__ int win_src(int j) {
    if (j < 1536) return j;
    if (j < 2048) { const int t = j - 1536, h = t >> 6, jj = t & 63; return 1544 + h * 64 + (jj >> 1) + 32 * (jj & 1); }
    if (j < 2176) return 2056 + (j - 2048);
    if (j < 2304) return 2184 + (j - 2176);
    if (j < 2432) { const int t = j - 2304, h = t >> 6, jj = t & 63; return 2312 + h * 64 + (jj >> 1) + 32 * (jj & 1); }
    if (j < 2560) return 2440 + (j - 2432);
    if (j < 2688) { const int t = j - 2560, h = t >> 6, jj = t & 63; return 2568 + h * 64 + (jj >> 1) + 32 * (jj & 1); }
    if (j < 2816) return 2696 + (j - 2688);
    if (j < 2824) return 1536 + (j - 2816);
    if (j < 2848) return j;
    return -1;
}
template <bool MAPPED>
__device__ __forceinline__ void transpose_item(const float* W, int K, int N, bf16_t* WT, int ndest, LAS float* scr, int item, int lane, const float* kgain = nullptr) {
    const int nblk = ndest / 32, kb = item / nblk, nb = item % nblk, k0 = 64 * kb, n0 = 32 * nb;
    const int sc = MAPPED ? win_src(n0 + (lane & 31)) : (n0 + (lane & 31));
#pragma unroll 8
    for (int i = 0; i < 32; ++i) { const int kk = 2 * i + (lane >> 5); float w = sc >= 0 ? W[(size_t)(k0 + kk) * N + sc] : 0.f; if (kgain) w *= kgain[k0 + kk]; scr[kk * 33 + (lane & 31)] = w; }
    asm volatile("s_waitcnt lgkmcnt(0)" ::: "memory");
    const int c = lane & 7;
#pragma unroll
    for (int j = 0; j < 4; ++j) { const int n = (lane >> 3) + 8 * j; const LAS float* s = scr + (8 * c) * 33 + n;
        u32x4 o; o.x = pk2(s[0 * 33], s[1 * 33]); o.y = pk2(s[2 * 33], s[3 * 33]); o.z = pk2(s[4 * 33], s[5 * 33]); o.w = pk2(s[6 * 33], s[7 * 33]);
        *(u32x4*)(WT + (size_t)(n0 + n) * K + k0 + 8 * c) = o; }
    asm volatile("s_waitcnt lgkmcnt(0)" ::: "memory");
}
template <int R>
__device__ __forceinline__ void rms_rows_to_bf16(const float* x0, const float* g, bf16_t* o0, int lane) {
    f32x4 v[R][4];
#pragma unroll
    for (int r = 0; r < R; ++r) { const f32x4* xr = (const f32x4*)(x0 + (size_t)r * 1024) + lane;
#pragma unroll
        for (int j = 0; j < 4; ++j) v[r][j] = xr[64 * j]; }
    const f32x4* gr = (const f32x4*)g + lane; f32x4 gg[4];
#pragma unroll
    for (int j = 0; j < 4; ++j) gg[j] = gr[64 * j];
#pragma unroll
    for (int r = 0; r < R; ++r) { float s = 0.f;
#pragma unroll
        for (int j = 0; j < 4; ++j) s += (v[r][j].x * v[r][j].x + v[r][j].y * v[r][j].y) + (v[r][j].z * v[r][j].z + v[r][j].w * v[r][j].w);
        const float rstd = 1.0f / sqrtf(wave_sum(s) * (1.f / 1024.f) + RMS_EPS);
        u32x2* o8 = (u32x2*)(o0 + (size_t)r * 1024) + lane;
#pragma unroll
        for (int j = 0; j < 4; ++j) { u32x2 w; w.x = pk2(v[r][j].x * rstd * gg[j].x, v[r][j].y * rstd * gg[j].y); w.y = pk2(v[r][j].z * rstd * gg[j].z, v[r][j].w * rstd * gg[j].w); o8[64 * j] = w; } }
}
template <bool NEXT, int R, bool HIN_BF, bool HOUT_BF>
__device__ __forceinline__ void residual_rows(const void* hres, const bf16_t* y, const float* gpost, void* hout, float* rstd_out, int lane) {
    u32x2 yw[R][4]; f32x4 hv[R][4];
#pragma unroll
    for (int r = 0; r < R; ++r) { const u32x2* yr = (const u32x2*)(y + (size_t)r * 1024) + lane;
#pragma unroll
        for (int j = 0; j < 4; ++j) yw[r][j] = yr[64 * j];
        if (HIN_BF) { const u32x2* hr = (const u32x2*)((const bf16_t*)hres + (size_t)r * 1024) + lane;
#pragma unroll
            for (int j = 0; j < 4; ++j) { const u32x2 w = hr[64 * j]; hv[r][j] = (f32x4){bf_lo(w.x), bf_hi(w.x), bf_lo(w.y), bf_hi(w.y)}; } }
        else { const f32x4* hr = (const f32x4*)((const float*)hres + (size_t)r * 1024) + lane;
#pragma unroll
            for (int j = 0; j < 4; ++j) hv[r][j] = hr[64 * j]; } }
    const f32x4* gp = (const f32x4*)gpost + lane; f32x4 g1[4];
#pragma unroll
    for (int j = 0; j < 4; ++j) g1[j] = gp[64 * j];
#pragma unroll
    for (int r = 0; r < R; ++r) { f32x4 yv[4]; float s = 0.f;
#pragma unroll
        for (int j = 0; j < 4; ++j) { const u32x2 w = yw[r][j]; yv[j] = (f32x4){bf_lo(w.x), bf_hi(w.x), bf_lo(w.y), bf_hi(w.y)}; s += (yv[j].x * yv[j].x + yv[j].y * yv[j].y) + (yv[j].z * yv[j].z + yv[j].w * yv[j].w); }
        const float rstd = 1.0f / sqrtf(wave_sum(s) * (1.f / 1024.f) + RMS_EPS); float s2 = 0.f;
#pragma unroll
        for (int j = 0; j < 4; ++j) { const f32x4 h = hv[r][j] + yv[j] * rstd * g1[j]; hv[r][j] = h; s2 += (h.x * h.x + h.y * h.y) + (h.z * h.z + h.w * h.w); }
        if (HOUT_BF) { u32x2* ho = (u32x2*)((bf16_t*)hout + (size_t)r * 1024) + lane;
#pragma unroll
            for (int j = 0; j < 4; ++j) { const f32x4 h = hv[r][j]; u32x2 w; w.x = pk2(h.x, h.y); w.y = pk2(h.z, h.w); ho[64 * j] = w; } }
        else { f32x4* ho = (f32x4*)((float*)hout + (size_t)r * 1024) + lane;
#pragma unroll
            for (int j = 0; j < 4; ++j) ho[64 * j] = hv[r][j]; }
        if (NEXT) { const float r2 = 1.0f / sqrtf(wave_sum(s2) * (1.f / 1024.f) + RMS_EPS); if (lane == 0) rstd_out[r] = r2;
        } }
}

struct KvMemOrder {
    int G, c;
    __device__ bool next(int i, pg8::Unit& u) const {
        const int L = i * G + c; if (L >= 256) return false;
        if (L < 128) { u.z = 0; u.pm = L >> 2; u.pn = L & 3; u.aoff = (size_t)u.pm * 256 * 1024 * 2; u.boff = (size_t)u.pn * 256 * 1024 * 2; u.coff = (size_t)u.pm * 256 * 1024 + u.pn * 256; }
        else { const int t = L - 128; u.z = 1; u.pm = t >> 5; u.pn = t & 31;
            u.aoff = (size_t)(WS_WXKV - WS_MN) + (size_t)(1024 + u.pm * 256) * 1024 * 2;
            u.boff = (size_t)(WS_MN - WS_WXKV) + (size_t)u.pn * 256 * 1024 * 2;
            u.coff = (size_t)(WS_VT - WS_KX) / 2 + (size_t)u.pm * 256 * 8192 + u.pn * 256; }
        return true;
    }
};
struct EpiKvMem {
    static constexpr bool PERM = true;
    bf16_t* O;
    __device__ __forceinline__ void operator()(const f32x4 (&acc)[2][2][4][2], const pg8::Unit& u, int wr, int wc, int fr, int fq) const {
        pg8::EpiBf16<0> e{O, u.z ? (size_t)8192 : (size_t)1024}; e(acc, u, wr, wc, fr, fq);
    }
};
struct CmpOrder {
    int G, c;
    __device__ bool next(int i, pg8::Unit& u) const {
        const int L = i * G + c; if (L >= 64) return false;
        u.z = L >> 4; u.pm = L & 15; u.pn = 0; const int g = u.z >> 1, kv = u.z & 1;
        u.aoff = ((size_t)u.pm * 256 * 16 * NPROJ + (kv ? C_VC : C_KC) + g * 64) * 2;
        u.boff = (size_t)kv * 256 * 1024 * 2;
        u.coff = (size_t)u.z * 4096 * 256 + (size_t)u.pm * 256 * 256;
        return true;
    }
};
struct XAttnOrder {
    int G, c; bool sv;
    __device__ bool next(int i, pg8::Unit& u) const {
        const int L = i * G + c; if (L >= 1024) return false;
        const int b = L >> 5, h = (L >> 3) & 3, rp = L & 7; u.z = 0; u.pm = b * 8 + rp; u.pn = h;
        u.aoff = ((size_t)u.pm * 256 * 1024 + h * 256) * 2;
        u.boff = sv ? ((size_t)h * 256 * 8192 + b * 256) * 2 : ((size_t)b * 256 * 1024 + h * 256) * 2;
        u.coff = (size_t)u.pm * 256 * 1024 + h * 256;
        return true;
    }
};


#define XB_TMO      128
#define XB_XCNT(j)  (256  + 64 * (j))
#define XB_XSUB(j)  (1280 + 64 * (j))
#define XB_XGEN(j)  (2304 + 64 * (j))
#define XB_TOP      3328
#define XB_TOPGEN   3392
#define XCD_BAR_WORDS 3456
#define XB_SPIN_CAP (1u << 18)
__device__ __forceinline__ unsigned xb_ld(unsigned* p)              { return __hip_atomic_load(p, __ATOMIC_RELAXED, __HIP_MEMORY_SCOPE_AGENT); }
__device__ __forceinline__ unsigned xb_add(unsigned* p, unsigned v) { return __hip_atomic_fetch_add(p, v, __ATOMIC_RELAXED, __HIP_MEMORY_SCOPE_AGENT); }
__device__ __forceinline__ unsigned xb_xcc_id() { return (unsigned)__builtin_amdgcn_s_getreg((3 << 11) | 20) & 0xFu; }
#define XB_SPIN(cond, bar) do { unsigned _sp = 0; while (cond) { __builtin_amdgcn_s_sleep(1); \
    if ((++_sp & 255u) == 0u) { if (xb_ld(&(bar)[XB_TMO])) break; if (_sp > XB_SPIN_CAP) { atomicAdd(&(bar)[XB_TMO], 1u); break; } } } } while (0)
__device__ __forceinline__ void xcd_barrier_complete(unsigned* bar, unsigned x, unsigned& nloc, unsigned& nx) {
    const unsigned G = gridDim.x * gridDim.y * gridDim.z;
    unsigned sum, cnt, mine, sp = 0u;
    for (;;) {
        sum = 0u; cnt = 0u; mine = 0u;
#pragma unroll
        for (unsigned j = 0; j < 16; ++j) { const unsigned c = xb_ld(&bar[XB_XCNT(j)]); sum += c; cnt += (c > 0u) ? 1u : 0u; mine = (j == x) ? c : mine; }
        if (sum == G) break;
        __builtin_amdgcn_s_sleep(1);
        if ((++sp & 255u) == 0u) { if (xb_ld(&bar[XB_TMO])) break; if (sp > XB_SPIN_CAP) { atomicAdd(&bar[XB_TMO], 1u); break; } }
    }
    nloc = mine > 0u ? mine : 1u; nx = cnt > 0u ? cnt : 1u;
}
__device__ __forceinline__ void xcd_barrier(unsigned* bar, unsigned x, volatile LAS unsigned* st, int tid) {
    asm volatile("s_waitcnt vmcnt(0)" ::: "memory");
    __syncthreads();
    if (tid == 0) {
        __builtin_amdgcn_s_waitcnt(0);
        unsigned nloc = st[0], nx = st[1];
        if (nloc == 0u) { xcd_barrier_complete(bar, x, nloc, nx); st[0] = nloc; st[1] = nx; }
        const unsigned old = xb_add(&bar[XB_XSUB(x)], 1u);
        const unsigned gen = old / nloc;
        if (old + 1u == (gen + 1u) * nloc) {
            __builtin_amdgcn_fence(__ATOMIC_RELEASE, "agent");
            asm volatile("s_waitcnt vmcnt(0)" ::: "memory");
            const unsigned og = xb_add(&bar[XB_TOP], 1u);
            const unsigned tg = og / nx;
            if (og + 1u == (tg + 1u) * nx) xb_add(&bar[XB_TOPGEN], 1u);
            else XB_SPIN(xb_ld(&bar[XB_TOPGEN]) == tg, bar);
            __builtin_amdgcn_fence(__ATOMIC_ACQUIRE, "agent");
            xb_add(&bar[XB_XGEN(x)], 1u);
            asm volatile("s_waitcnt vmcnt(0)" ::: "memory");
        } else {
            XB_SPIN(xb_ld(&bar[XB_XGEN(x)]) == gen, bar);
            __builtin_amdgcn_fence(__ATOMIC_ACQUIRE, "agent");
            asm volatile("s_waitcnt vmcnt(0)" ::: "memory");
        }
    }
    __syncthreads();
}
constexpr int CW_BAR = 4096;
constexpr int LDS_BARST = 143360;

__global__ void __launch_bounds__(NWAVES * 64, 2) layer_fwd(Args args) {
    extern __shared__ __attribute__((aligned(16))) unsigned char lds_raw[];
    LAS unsigned char* lds = (LAS unsigned char*)lds_raw;
    int wave_s = __builtin_amdgcn_readfirstlane((int)threadIdx.x >> 6);
    const int G = gridDim.x, bx = blockIdx.x;
    volatile LAS unsigned* barst = (volatile LAS unsigned*)(lds + LDS_BARST);
    unsigned xcc = 0u;
    if (args.ph_hi - args.ph_lo > 1) {
        if (threadIdx.x == 0) { barst[0] = 0u; barst[1] = 0u; }
        xcc = xb_xcc_id();
        if (threadIdx.x == 0) (void)xb_add((unsigned*)(args.ws + WS_CTL) + CW_BAR + XB_XCNT(xcc), 1u);
        __syncthreads();
    }
#define PHASE_IDS asm volatile("" : "+s"(wave_s)); auto kp_ = __builtin_amdgcn_kernarg_segment_ptr(); asm volatile("" : "+s"(kp_)); const Args* ap = (const Args*)kp_; unsigned char* const ws = ap->ws; (void)ws; const int wave = wave_s, lane = (int)__builtin_amdgcn_mbcnt_hi(~0u, __builtin_amdgcn_mbcnt_lo(~0u, 0u)), tid = wave * 64 + lane, gw = bx * NWAVES + wave, NGW = G * NWAVES; (void)tid; (void)gw; (void)NGW; (void)lane

#define INP(k) (ap->in[k])
#define x_ INP(0)
#define mem_ INP(1)
#define g_mix_pre INP(2)
#define w_in INP(3)
#define b_forget INP(4)
#define w_ck1 INP(5)
#define w_ck2 INP(6)
#define w_cv1 INP(7)
#define w_cv2 INP(8)
#define pe_k INP(9)
#define pe_v INP(10)
#define w_mix_out INP(11)
#define g_mix_post INP(12)
#define g_x_pre INP(13)
#define g_mem INP(14)
#define w_xq INP(15)
#define w_xkv INP(16)
#define w_xo INP(17)
#define g_x_post INP(18)
#define g_mlp_pre INP(19)
#define w_up INP(20)
#define w_down INP(21)
#define g_mlp_post INP(22)
#define OUTP (ap->out)
#define ctl ((unsigned*)(ws + WS_CTL))
#define WinT ((bf16_t*)(ws + WS_WIN))
#define WoutT ((bf16_t*)(ws + WS_WOUT))
#define WxqT ((bf16_t*)(ws + WS_WXQ))
#define WxkvT ((bf16_t*)(ws + WS_WXKV))
#define WxoT ((bf16_t*)(ws + WS_WXO))
#define WupT ((bf16_t*)(ws + WS_WUP))
#define WdnT ((bf16_t*)(ws + WS_WDN))
#define Wc1T ((bf16_t*)(ws + WS_WC1))
#define ROPE ((f32x2*)(ws + WS_ROPE))
#define BIAS1 ((float*)(ws + WS_BIAS1))
#define FG ((float*)(ws + WS_FG))
#define C2B ((float*)(ws + WS_C2))
#define Y ((float*)(ws + WS_Y))
#define KC ((bf16_t*)(ws + WS_KC))
#define MN ((bf16_t*)(ws + WS_MN))
#define KX ((bf16_t*)(ws + WS_KX))
#define VT ((bf16_t*)(ws + WS_VT))
#define NB ((bf16_t*)(ws + WS_N))
#define GB ((bf16_t*)(ws + WS_G))
#define AO ((bf16_t*)(ws + WS_AO))
#define PROJ ((bf16_t*)(ws + WS_PROJ))
#define QX ((bf16_t*)(ws + WS_QX))
#define SB ((float*)(ws + WS_S))
#define PB ((bf16_t*)(ws + WS_AO))
#define XOIN ((bf16_t*)(ws + WS_QX))
#define UB ((bf16_t*)(ws + WS_U))
#define H1B ((bf16_t*)(ws + WS_S))
#define RSTD2 ((float*)(ws + WS_Y))
#define RSTD3 ((float*)(ws + WS_Y + MiB))
#define XSB ((float*)(ws + WS_Y + 2 * MiB))
    const int lo = args.ph_lo, hi_ph = args.ph_hi;
#ifndef PHASE_MASK
#define PHASE_MASK 0xffff
#endif
#define IN(k) (((PHASE_MASK >> (k)) & 1) && lo <= (k) && (k) < hi_ph)
#define SEAM(k) do { if (lo <= (k) && (k) + (((k) == 5 || (k) == 8 || (k) == 11) ? 2 : 1) < hi_ph) { if ((k) == 0) cg::this_grid().sync(); else { PHASE_IDS; xcd_barrier(ctl + CW_BAR, xcc, barst, tid); } } } while (0)

    if (IN(0)) { PHASE_IDS;
        LAS float* scr = (LAS float*)(lds + wave * 16384);
        constexpr int I_IN = 16 * 96, I_SQ = 16 * 32, I_KV = 16 * 64, I_UP = 16 * 128, I_DN = 64 * 32, I_C1 = 16 * 4;
        constexpr int NITEMS = I_IN + 3 * I_SQ + I_KV + I_UP + I_DN + 4 * I_C1;
        for (int it = gw; it < NITEMS; it += NGW) {
            int r = it;
            if (r < I_IN) { transpose_item<true>(w_in, 1024, 2848, WinT, 3072, scr, r, lane); continue; } r -= I_IN;
            if (r < I_SQ) { transpose_item<false>(w_mix_out, 1024, 1024, WoutT, 1024, scr, r, lane); continue; } r -= I_SQ;
            if (r < I_SQ) { transpose_item<false>(w_xq, 1024, 1024, WxqT, 1024, scr, r, lane, g_x_pre); continue; } r -= I_SQ;
            if (r < I_SQ) { transpose_item<false>(w_xo, 1024, 1024, WxoT, 1024, scr, r, lane); continue; } r -= I_SQ;
            if (r < I_KV) { transpose_item<false>(w_xkv, 1024, 2048, WxkvT, 2048, scr, r, lane); continue; } r -= I_KV;
            if (r < I_UP) { transpose_item<false>(w_up, 1024, 4096, WupT, 4096, scr, r, lane, g_mlp_pre); continue; } r -= I_UP;
            if (r < I_DN) { transpose_item<false>(w_down, 4096, 1024, WdnT, 1024, scr, r, lane); continue; } r -= I_DN;
            { const int q = r / I_C1, rr = r % I_C1, kv = q >> 1, a = q & 1; const float* W1 = kv ? w_cv1 : w_ck1;
              transpose_item<false>(W1 + (size_t)a * 1024 * 128, 1024, 128, Wc1T + (size_t)kv * 256 * 1024 + (size_t)a * 128 * 1024, 128, scr, rr, lane); }
        }
        for (int m = gw * 4; m < MTOK; m += NGW * 4) rms_rows_to_bf16<4>(x_ + (size_t)m * DM, g_mix_pre, NB + (size_t)m * DM, lane);
        for (int m = gw * 4; m < MMEM; m += NGW * 4) rms_rows_to_bf16<4>(mem_ + (size_t)m * DM, g_mem, MN + (size_t)m * DM, lane);
        for (int i = bx * 512 + tid; i < SEQ * 32; i += G * 512) { const int pos = i >> 5, k = i & 31;
            const float inv = powf(10000.0f, -(float)k / 32.0f); const float ang = (float)pos * inv; float sn, cs; sincosf(ang, &sn, &cs); ROPE[i] = (f32x2){cs, sn}; }
        for (int o_ = gw; o_ < 256; o_ += NGW) { const int kv = o_ >> 7, c = o_ & 127; const float* W1 = kv ? w_cv1 : w_ck1; const float* pe = kv ? pe_v : pe_k; float s = 0.f;
            for (int kk = lane; kk < 2048; kk += 64) s += pe[kk] * W1[(size_t)kk * 128 + c];
            s = wave_sum(s); if (lane == 0) BIAS1[o_] = s; }
    }
    SEAM(0);
    if (IN(1)) { PHASE_IDS;
        { pg8::Gemm g{(const char*)NB, (const char*)WinT, 1024, 1024, 128, 128, 1024}; pg8::StaticOrder S; S.init(MTOK, NPROJ, G, bx, 1024, 1024, NPROJ);
          pg8::EpiProj E{PROJ, FG}; pg8::gemm_phase(lds, g, S, E, tid); }
        { pg8::Gemm g{(const char*)MN, (const char*)WxkvT, 1024, 1024, 128, 128, 1024}; KvMemOrder S{G, bx}; EpiKvMem E{KX}; pg8::gemm_phase(lds, g, S, E, tid); }
    }
    SEAM(1);
    if (IN(2)) { PHASE_IDS;
        const int nb = G > 64 ? 64 : 0;
        if (bx < 64 || nb == 0) {
            pg8::Gemm g{(const char*)PROJ, (const char*)Wc1T, 16 * NPROJ, 1024, NPROJ * 2, 128, 1024}; CmpOrder S{nb ? 64 : G, bx}; pg8::EpiF32 E{Y, 256, 1.0f};
            pg8::gemm_phase(lds, g, S, E, tid);
        }
        if (bx >= nb) {
            const int egw = (bx - nb) * NWAVES + wave, ENGW = (G - nb) * NWAVES;
            for (int s = egw; s < BATCH * 8; s += ENGW) { const int b = s >> 3, h = s & 7; const float bf = b_forget[h];
                const float* fp = FG + ((size_t)b * SEQ + lane * 32) * 32 + h; float v[32]; float run = 0.f;
#pragma unroll
                for (int i = 0; i < 32; ++i) { const float z = fp[(size_t)i * 32] + bf; const float ls = fminf(z, 0.f) - log1pf(expf(-fabsf(z))); run += ls; v[i] = run; }
                float incl = run;
#pragma unroll
                for (int o_ = 1; o_ < 64; o_ <<= 1) { const float t = __shfl_up(incl, o_); if (lane >= o_) incl += t; }
                const float excl = incl - run; float* cp = C2B + (size_t)s * SEQ + lane * 32;
#pragma unroll
                for (int i = 0; i < 32; ++i) cp[i] = (v[i] + excl) * att::LOG2E; }
            for (int tsk = egw; tsk < BATCH * 8 * 32; tsk += ENGW) { const int bh = tsk >> 5, ch = tsk & 31, b = bh >> 3, h = bh & 7;
                const bf16_t* base = PROJ + ((size_t)b * SEQ + ch * 64 + (lane >> 3)) * NPROJ + h * 64 + (lane & 7) * 8; float mq = 0.f, mk = 0.f;
#pragma unroll
                for (int p = 0; p < 8; ++p) { const u32x4 wq = *(const u32x4*)(base + (size_t)p * 8 * NPROJ + C_FQ), wk = *(const u32x4*)(base + (size_t)p * 8 * NPROJ + C_FK); float sq = 0.f, sk = 0.f;
#pragma unroll
                    for (int i = 0; i < 4; ++i) { const float a = bf_lo(wq[i]), c = bf_hi(wq[i]), d = bf_lo(wk[i]), e = bf_hi(wk[i]); sq += a * a + c * c; sk += d * d + e * e; }
                    sq += __shfl_xor(sq, 1); sq += __shfl_xor(sq, 2); sq += __shfl_xor(sq, 4); sk += __shfl_xor(sk, 1); sk += __shfl_xor(sk, 2); sk += __shfl_xor(sk, 4);
                    mq = fmaxf(mq, sq); mk = fmaxf(mk, sk); }
                mq = wave_max(mq); mk = wave_max(mk);
                if (lane == 0) { atomicMax(&ctl[CW_NORM + 2 * bh], __float_as_uint(mq)); atomicMax(&ctl[CW_NORM + 2 * bh + 1], __float_as_uint(mk)); } }
            for (int m = egw; m < MTOK; m += ENGW) { const int pos = m & (SEQ - 1); const int cl = 4 * (lane & 31);
                bf16_t* p = PROJ + (size_t)m * NPROJ + (lane < 32 ? C_KS : C_KW) + cl; const int i0 = (cl & 63) >> 1;
                const u32x2 w = *(const u32x2*)p; const f32x2 cs0 = ROPE[pos * 32 + i0], cs1 = ROPE[pos * 32 + i0 + 1]; u32x2 o;
                { const float x1 = bf_lo(w.x), x2 = bf_hi(w.x); o.x = pk2(x1 * cs0.x - x2 * cs0.y, x2 * cs0.x + x1 * cs0.y); }
                { const float x1 = bf_lo(w.y), x2 = bf_hi(w.y); o.y = pk2(x1 * cs1.x - x2 * cs1.y, x2 * cs1.x + x1 * cs1.y); }
                *(u32x2*)p = o; }
        }
    }
    SEAM(2);
    if (IN(3)) { PHASE_IDS;
        LAS float* hs = (LAS float*)(lds + wave * 512);
        for (int idx = gw; idx < 4 * BATCH * 128; idx += NGW) { const int z = idx >> 12, rem = idx & 4095, b = rem >> 7, n = rem & 127, g = z >> 1, kv = z & 1;
            bf16_t* dst = KC + (((size_t)(b * 2 + g) * 2 + kv) * 128 + n) * 64;
            if (n == 127) { dst[lane] = 0; continue; }
            const float* y0 = Y + ((size_t)z * 4096 + b * 128 + n) * 256; const float* y1 = y0 + 256 + 128;
#pragma unroll
            for (int q = 0; q < 2; ++q) { const int c = lane + 64 * q; const float a = y0[c] + y1[c] + BIAS1[kv * 128 + c]; hs[c] = a / (1.f + __expf(-a)); }
            asm volatile("s_waitcnt lgkmcnt(0)" ::: "memory");
            const float* W2 = kv ? w_cv2 : w_ck2; const int js = kv ? lane : ((lane >> 1) + 32 * (lane & 1)); float acc = 0.f;
#pragma unroll 8
            for (int c = 0; c < 128; ++c) acc += hs[c] * W2[c * 64 + js];
            dst[lane] = (bf16_t)(pk2(acc, 0.f) & 0xffffu);
            asm volatile("s_waitcnt lgkmcnt(0)" ::: "memory"); }
    }
    SEAM(3);
    if (IN(4)) { PHASE_IDS;
        LAS int* qw = (LAS int*)(lds + att::L_MISC);
        const int myq = (int)(xb_xcc_id() & 7u);
        for (int qi = 0; qi < 8; ++qi) {
            const int q = (myq + qi) & 7;
            for (;;) {
                if (tid == 0) qw[0] = (int)atomicAdd(&ctl[CW_QUEUE + 64 * q], 1u);
                __syncthreads();
                const int u = qw[0];
                __syncthreads();
                if (u >= 512) break;
                const int b = q + 8 * (u >> 7), r = u & 127;
                if (r < 64) att::nsa_unit(lds, b, r & 1, 31 - (r >> 1), PROJ, KC, FG, ROPE, AO, wave, lane);
                else { const int v = r - 64; att::fox_unit(lds, b, v & 7, 7 - (v >> 3), PROJ, C2B, (const float*)(ctl + CW_NORM + 2 * (b * 8 + (v & 7))), AO, wave, lane); }
            }
        }
    }
    SEAM(4);
    if (IN(5)) { PHASE_IDS; pg8::Gemm g{(const char*)AO, (const char*)WoutT, 1024, 1024, 128, 128, 1024}; pg8::StaticOrder S; S.init(MTOK, 1024, G, bx, 1024, 1024, 1024);
        pg8::EpiResid<false, true, true> E{x_, H1B, g_mix_post, RSTD2, XSB, ctl + CW_XCNT, lds + 131072}; pg8::gemm_phase(lds, g, S, E, tid); }
    SEAM(5);
    if (IN(7)) { PHASE_IDS; pg8::Gemm g{(const char*)H1B, (const char*)WxqT, 1024, 1024, 128, 128, 1024}; pg8::StaticOrder S; S.init(MTOK, 1024, G, bx, 1024, 1024, 1024);
        pg8::EpiBf16<0> E{QX, 1024, RSTD2}; pg8::gemm_phase(lds, g, S, E, tid); }
    SEAM(7);
    if (IN(8)) { PHASE_IDS; pg8::Gemm g{(const char*)QX, (const char*)KX, 1024, 1024, 128, 128, 256}; XAttnOrder S{G, bx, false};
        pg8::EpiSoftmax E{PB, 1024, 0.0625f * att::LOG2E, lds + 131072}; pg8::gemm_phase(lds, g, S, E, tid); }
    SEAM(8);
    if (IN(10)) { PHASE_IDS; pg8::Gemm g{(const char*)PB, (const char*)VT, 1024, 8192, 128, 128, 256}; XAttnOrder S{G, bx, true};
        pg8::EpiBf16<0> E{XOIN, 1024}; pg8::gemm_phase(lds, g, S, E, tid); }
    SEAM(10);
    if (IN(11)) { PHASE_IDS; pg8::Gemm g{(const char*)XOIN, (const char*)WxoT, 1024, 1024, 128, 128, 1024}; pg8::StaticOrder S; S.init(MTOK, 1024, G, bx, 1024, 1024, 1024);
        pg8::EpiResid<true, true, true> E{H1B, GB, g_x_post, RSTD3, XSB + (size_t)2 * MTOK * 4, ctl + CW_XCNT + 2 * 256 * 64, lds + 131072}; pg8::gemm_phase(lds, g, S, E, tid); }
    SEAM(11);
    if (IN(13)) { PHASE_IDS; pg8::Gemm g{(const char*)GB, (const char*)WupT, 1024, 1024, 128, 128, 1024}; pg8::StaticOrder S; S.init(MTOK, FF, G, bx, 1024, 1024, FF);
        pg8::EpiBf16<1> E{UB, FF, RSTD3}; pg8::gemm_phase(lds, g, S, E, tid); }
    SEAM(13);
    if (IN(14)) { PHASE_IDS; pg8::Gemm g{(const char*)UB, (const char*)WdnT, FF, FF, 128, 128, FF}; pg8::StaticOrder S; S.init(MTOK, 1024, G, bx, FF, FF, 1024);
        pg8::EpiResid<true, false, false> E{GB, OUTP, g_mlp_post, nullptr, XSB + (size_t)4 * MTOK * 4, ctl + CW_XCNT + 4 * 256 * 64, lds + 131072}; pg8::gemm_phase(lds, g, S, E, tid); }
#undef IN
#undef SEAM
}

extern "C" void kernel_launch(void* const* d_in, const int* in_sizes, int n_in, void* d_out, int out_size, void* d_ws, size_t ws_size, hipStream_t stream) {
    static int grid = 0;
    if (grid == 0) {
        if (n_in != 23 || out_size != MTOK * DM || ws_size < WS_END) { fprintf(stderr, "kernel_launch: unexpected problem (n_in %d, out %d, ws %zu)\n", n_in, out_size, ws_size); grid = -1; return; }
        int dev = 0, cus = 0, per_cu = 0;
        hipGetDevice(&dev); hipDeviceGetAttribute(&cus, hipDeviceAttributeMultiprocessorCount, dev);
        if (hipFuncSetAttribute((const void*)layer_fwd, hipFuncAttributeMaxDynamicSharedMemorySize, LDS_BYTES) != hipSuccess) { fprintf(stderr, "kernel_launch: hipFuncSetAttribute failed\n"); grid = -1; return; }
        if (hipOccupancyMaxActiveBlocksPerMultiprocessor(&per_cu, (const void*)layer_fwd, NWAVES * 64, LDS_BYTES) != hipSuccess || per_cu < 1) { fprintf(stderr, "kernel_launch: occupancy query says %d\n", per_cu); per_cu = 1; }
        (void)hipGetLastError();
        grid = cus;
    }
    if (grid < 0) return;
    if (hipMemsetAsync((char*)d_ws + WS_CTL, 0, 1 << 20, stream) != hipSuccess) { fprintf(stderr, "kernel_launch: memset failed\n"); return; }
    Args a{};
    for (int i = 0; i < 23; ++i) a.in[i] = (const float*)d_in[i];
    a.out = (float*)d_out; a.ws = (unsigned char*)d_ws;
#if MK_ONE_LAUNCH
    a.ph_lo = 0; a.ph_hi = NPHASE;
    void* kargs[] = {&a};
    hipError_t e = hipLaunchCooperativeKernel((const void*)layer_fwd, dim3(grid), dim3(NWAVES * 64), kargs, LDS_BYTES, stream);
    if (e != hipSuccess) fprintf(stderr, "kernel_launch: cooperative launch failed: %s (grid %d)\n", hipGetErrorString(e), grid);
#else
    for (int p = 0; p < NPHASE; ++p) { a.ph_lo = p; a.ph_hi = p + 1; hipLaunchKernelGGL(layer_fwd, dim3(grid), dim3(NWAVES * 64), LDS_BYTES, stream, a); }
#endif
}
```

```cpp
#include <hip/hip_runtime.h>
#include <hip/hip_cooperative_groups.h>
#include <cstdio>
#include <cstdint>
namespace cg = cooperative_groups;

#ifndef MK_ONE_LAUNCH
#define MK_ONE_LAUNCH 1
#endif

#define LAS __attribute__((address_space(3)))
typedef unsigned short bf16_t;
typedef short bf16x8 __attribute__((ext_vector_type(8)));
typedef short s16x4 __attribute__((ext_vector_type(4)));
typedef float f32x2 __attribute__((ext_vector_type(2)));
typedef float f32x4 __attribute__((ext_vector_type(4)));
typedef float f32x16 __attribute__((ext_vector_type(16)));
typedef unsigned u32x2 __attribute__((ext_vector_type(2)));
typedef unsigned u32x4 __attribute__((ext_vector_type(4)));

constexpr int BATCH = 32, SEQ = 2048, DM = 1024, MTOK = BATCH * SEQ;
constexpr int NPROJ = 3072;
constexpr int MEMLEN = 256, MMEM = BATCH * MEMLEN;
constexpr int FF = 4096;
constexpr float RMS_EPS = 1e-6f;
constexpr int C_FQ = 0, C_FK = 512, C_FV = 1024, C_NQ = 1536, C_KC = 2048, C_VC = 2176, C_KS = 2304, C_VS = 2432, C_KW = 2560, C_VW = 2688, C_FF = 2816, C_NG = 2824;

constexpr size_t MiB = 1u << 20;
constexpr size_t WS_CTL = 0;
constexpr size_t WS_WIN = 2 * MiB;
constexpr size_t WS_WOUT = 8 * MiB;
constexpr size_t WS_WXQ = 10 * MiB;
constexpr size_t WS_WXKV = 12 * MiB;
constexpr size_t WS_WXO = 16 * MiB;
constexpr size_t WS_WUP = 18 * MiB;
constexpr size_t WS_WDN = 26 * MiB;
constexpr size_t WS_WC1 = 34 * MiB;
constexpr size_t WS_ROPE = 36 * MiB;
constexpr size_t WS_BIAS1 = 37 * MiB;
constexpr size_t WS_FG = 40 * MiB;
constexpr size_t WS_C2 = 48 * MiB;
constexpr size_t WS_Y = 50 * MiB;
constexpr size_t WS_KC = 82 * MiB;
constexpr size_t WS_MN = 84 * MiB;
constexpr size_t WS_KX = 100 * MiB;
constexpr size_t WS_VT = 116 * MiB;
constexpr size_t WS_N = 132 * MiB;
constexpr size_t WS_G = 260 * MiB;
constexpr size_t WS_AO = 388 * MiB;
constexpr size_t WS_PROJ = 516 * MiB;
constexpr size_t WS_QX = 516 * MiB;
constexpr size_t WS_S = 644 * MiB;
constexpr size_t WS_U = 388 * MiB;
constexpr size_t WS_END = 900 * MiB;

constexpr int CW_QUEUE = 64;
constexpr int CW_XCNT = 16384;
constexpr int CW_NORM = 8192;

__device__ __forceinline__ unsigned pk2(float lo, float hi) {
    typedef __bf16 b2 __attribute__((ext_vector_type(2)));
    f32x2 v = {lo, hi}; b2 b = __builtin_convertvector(v, b2); return __builtin_bit_cast(unsigned, b);
}
__device__ __forceinline__ float bf_lo(unsigned u) { return __uint_as_float(u << 16); }
__device__ __forceinline__ float bf_hi(unsigned u) { return __uint_as_float(u & 0xffff0000u); }
__device__ __forceinline__ float wave_sum(float v) {
#pragma unroll
    for (int o = 1; o < 64; o <<= 1) v += __shfl_xor(v, o);
    return v;
}
__device__ __forceinline__ float wave_max(float v) {
#pragma unroll
    for (int o = 1; o < 64; o <<= 1) v = fmaxf(v, __shfl_xor(v, o));
    return v;
}

namespace pg8 {
constexpr int BM = 256, BK = 64, HALF = 128, HTB = HALF * BK * 2, STAGE_BYTES = 8 * HTB, NXCD = 8, WGM = 4;

__host__ __device__ __forceinline__ int lds_byte(int r, int c) { const int st = (r >> 4) * 2 + (c >> 5), rr = r & 15, cc = c & 31, ob = rr * 64 + cc * 2; return st * 1024 + (ob ^ (((ob >> 9) & 1) << 5)); }
__host__ __device__ __forceinline__ void stage_rc(int b, int& R, int& C) { const int st = b / 1024, sb = b % 1024, swz = sb ^ (((sb >> 9) & 1) << 5); R = (st >> 1) * 16 + swz / 64; C = (st & 1) * 32 + (swz % 64) / 2; }
__host__ __device__ __forceinline__ int perm32(int rho) { const int n = rho >> 4, i = rho & 15; return 8 * (i >> 2) + 4 * n + (i & 3); }

struct Unit { int pm, pn, z; size_t aoff, boff, coff; };
struct Gemm { const char* A; const char* Bt; unsigned lda, ldb; unsigned kstepA, kstepB; int K; };

struct StaticOrder {
    int nM, nN, nwg, G, c; size_t lda, ldb, ldc;
    __device__ void init(int M, int N, int G_, int c_, size_t lda_, size_t ldb_, size_t ldc_) { nM = M / BM; nN = N / BM; nwg = nM * nN; G = G_; c = c_; lda = lda_; ldb = ldb_; ldc = ldc_; }
    __device__ bool next(int i, Unit& u) const {
        const long L = (long)i * G + c; if (L >= nwg) return false;
        int wgid = (int)L; { const int q = nwg / NXCD, r = nwg % NXCD, xcd = wgid % NXCD, off = wgid / NXCD; wgid = (xcd < r ? xcd * (q + 1) : r * (q + 1) + (xcd - r) * q) + off; }
        const int nig = WGM * nN, gid = wgid / nig, fm = gid * WGM, gsz = (nM - fm) < WGM ? (nM - fm) : WGM;
        u.pm = fm + ((wgid % nig) % gsz); u.pn = (wgid % nig) / gsz; u.z = 0;
        u.aoff = (size_t)u.pm * BM * lda * 2; u.boff = (size_t)u.pn * BM * ldb * 2; u.coff = (size_t)u.pm * BM * ldc + (size_t)u.pn * BM;
        return true;
    }
};

template <int ACT  > struct EpiBf16 {
    static constexpr bool PERM = true;
    bf16_t* O; size_t ldc; const float* rscale = nullptr;
    __device__ __forceinline__ void operator()(const f32x4 (&acc)[2][2][4][2], const Unit& u, int wr, int wc, int fr, int fq) const {
        bf16_t* base = O + u.coff + (size_t)(wr * 64 + fr) * ldc + wc * 32 + 8 * fq;
#pragma unroll
        for (int ai = 0; ai < 2; ++ai)
#pragma unroll
            for (int m = 0; m < 4; ++m) { bf16_t* rowp = base + (size_t)(ai * HALF + m * 16) * ldc;
                const float rs = rscale ? rscale[u.pm * BM + wr * 64 + fr + ai * HALF + m * 16] : 1.f;
#pragma unroll
                for (int bj = 0; bj < 2; ++bj) { f32x4 v0 = acc[ai][bj][m][0] * rs, v1 = acc[ai][bj][m][1] * rs;
                    if (ACT == 1) {
#pragma unroll
                        for (int i = 0; i < 4; ++i) { const float a = fmaxf(v0[i], 0.f), b = fmaxf(v1[i], 0.f); v0[i] = a * a; v1[i] = b * b; } }
                    u32x4 w; w.x = pk2(v0[0], v0[1]); w.y = pk2(v0[2], v0[3]); w.z = pk2(v1[0], v1[1]); w.w = pk2(v1[2], v1[3]);
                    *(u32x4*)(rowp + bj * HALF) = w; } }
    }
};
struct EpiProj {
    static constexpr bool PERM = true;
    bf16_t* O; float* FG;
    __device__ __forceinline__ void operator()(const f32x4 (&acc)[2][2][4][2], const Unit& u, int wr, int wc, int fr, int fq) const {
        if (u.pn < 11) {
            bf16_t* base = O + u.coff + (size_t)(wr * 64 + fr) * NPROJ + wc * 32 + 8 * fq;
#pragma unroll
            for (int ai = 0; ai < 2; ++ai)
#pragma unroll
                for (int m = 0; m < 4; ++m) { bf16_t* rowp = base + (size_t)(ai * HALF + m * 16) * NPROJ;
#pragma unroll
                    for (int bj = 0; bj < 2; ++bj) { const f32x4 v0 = acc[ai][bj][m][0], v1 = acc[ai][bj][m][1];
                        u32x4 w; w.x = pk2(v0[0], v0[1]); w.y = pk2(v0[2], v0[3]); w.z = pk2(v1[0], v1[1]); w.w = pk2(v1[2], v1[3]);
                        *(u32x4*)(rowp + bj * HALF) = w; } }
        } else if (wc == 0) {
            float* base = FG + (size_t)(u.pm * BM + wr * 64 + fr) * 32 + 8 * fq;
#pragma unroll
            for (int ai = 0; ai < 2; ++ai)
#pragma unroll
                for (int m = 0; m < 4; ++m) { float* rowp = base + (size_t)(ai * HALF + m * 16) * 32;
                    *(f32x4*)(rowp) = acc[ai][0][m][0]; *(f32x4*)(rowp + 4) = acc[ai][0][m][1]; }
        }
    }
};
struct EpiF32 {
    static constexpr bool PERM = false;
    float* O; size_t ldc; float scale;
    __device__ __forceinline__ void operator()(const f32x4 (&acc)[2][2][4][2], const Unit& u, int wr, int wc, int fr, int fq) const {
        float* base = O + u.coff + (size_t)(wr * 64 + fr) * ldc + wc * 32 + 4 * fq;
#pragma unroll
        for (int ai = 0; ai < 2; ++ai)
#pragma unroll
            for (int m = 0; m < 4; ++m) { float* rowp = base + (size_t)(ai * HALF + m * 16) * ldc;
#pragma unroll
                for (int bj = 0; bj < 2; ++bj)
#pragma unroll
                    for (int n = 0; n < 2; ++n) *(f32x4*)(rowp + bj * HALF + n * 16) = acc[ai][bj][m][n] * scale; }
    }
};

struct EpiSoftmax {
    static constexpr bool PERM = true;
    bf16_t* O; size_t ldc; float scale; LAS unsigned char* xl;
    __device__ __forceinline__ void operator()(f32x4 (&acc)[2][2][4][2], const Unit& u, int wr, int wc, int fr, int fq) const {
        LAS f32x2* X = (LAS f32x2*)xl;
        float mown[2][4];
#pragma unroll
        for (int ai = 0; ai < 2; ++ai)
#pragma unroll
            for (int m = 0; m < 4; ++m) {
                float mx = -INFINITY;
#pragma unroll
                for (int bj = 0; bj < 2; ++bj)
#pragma unroll
                    for (int n = 0; n < 2; ++n) { const f32x4 v = acc[ai][bj][m][n]; mx = fmaxf(mx, fmaxf(fmaxf(v[0], v[1]), fmaxf(v[2], v[3]))); }
                mx = fmaxf(mx, __shfl_xor(mx, 16)); mx = fmaxf(mx, __shfl_xor(mx, 32));
                const float ms = mx * scale; float l = 0.f;
#pragma unroll
                for (int bj = 0; bj < 2; ++bj)
#pragma unroll
                    for (int n = 0; n < 2; ++n) { f32x4 v = acc[ai][bj][m][n];
#pragma unroll
                        for (int i = 0; i < 4; ++i) { v[i] = __builtin_amdgcn_exp2f(v[i] * scale - ms); l += v[i]; }
                        acc[ai][bj][m][n] = v; }
                l += __shfl_xor(l, 16); l += __shfl_xor(l, 32);
                mown[ai][m] = ms;
                if (fq == 0) X[(ai * HALF + wr * 64 + m * 16 + fr) * 4 + wc] = (f32x2){ms, l};
            }
        asm volatile("s_waitcnt lgkmcnt(0)" ::: "memory"); __builtin_amdgcn_s_barrier(); asm volatile("" ::: "memory");
        bf16_t* base = O + u.coff + (size_t)(wr * 64 + fr) * ldc + wc * 32 + 8 * fq;
#pragma unroll
        for (int ai = 0; ai < 2; ++ai)
#pragma unroll
            for (int m = 0; m < 4; ++m) {
                const LAS f32x4* xr = (const LAS f32x4*)(X + (ai * HALF + wr * 64 + m * 16 + fr) * 4);
                const f32x4 a = xr[0], b = xr[1];
                const float M = fmaxf(fmaxf(a[0], a[2]), fmaxf(b[0], b[2]));
                const float L = (a[1] * __builtin_amdgcn_exp2f(a[0] - M) + a[3] * __builtin_amdgcn_exp2f(a[2] - M)) + (b[1] * __builtin_amdgcn_exp2f(b[0] - M) + b[3] * __builtin_amdgcn_exp2f(b[2] - M));
                const float f = __builtin_amdgcn_exp2f(mown[ai][m] - M) / L;
                bf16_t* rowp = base + (size_t)(ai * HALF + m * 16) * ldc;
#pragma unroll
                for (int bj = 0; bj < 2; ++bj) { const f32x4 v0 = acc[ai][bj][m][0] * f, v1 = acc[ai][bj][m][1] * f;
                    u32x4 w; w.x = pk2(v0[0], v0[1]); w.y = pk2(v0[2], v0[3]); w.z = pk2(v1[0], v1[1]); w.w = pk2(v1[2], v1[3]);
                    *(u32x4*)(rowp + bj * HALF) = w; }
            }
        asm volatile("s_waitcnt lgkmcnt(0)" ::: "memory"); __builtin_amdgcn_s_barrier(); asm volatile("" ::: "memory");
    }
};

template <bool HIN_BF, bool HOUT_BF, bool NEXT> struct EpiResid {
    static constexpr bool PERM = true;
    const void* hres; void* hout; const float* gpost; float* rstd_out; float* xs; unsigned* cnt; LAS unsigned char* xl;
    __device__ __forceinline__ void stats(const float (&part)[2][4], const Unit& u, int bank, int wr, int wc, int fr, int fq) const {
        LAS float* P = (LAS float*)xl;
        LAS float* S = (LAS float*)(xl + 4096);
        const int wid = wr * 4 + wc, lane = fq * 16 + fr;
#pragma unroll
        for (int ai = 0; ai < 2; ++ai)
#pragma unroll
            for (int m = 0; m < 4; ++m) { float v = part[ai][m]; v += __shfl_xor(v, 16); v += __shfl_xor(v, 32); if (fq == 0) P[(ai * HALF + wr * 64 + m * 16 + fr) * 4 + wc] = v; }
        asm volatile("s_waitcnt lgkmcnt(0)" ::: "memory"); __builtin_amdgcn_s_barrier(); asm volatile("" ::: "memory");
        const int row = wid * 32 + (lane & 31);
        unsigned* slot = (unsigned*)(xs + ((size_t)bank * MTOK + (size_t)u.pm * BM + row) * 4);
        if (lane < 32) { const f32x4 p = *(const LAS f32x4*)(P + row * 4); const float t = (p[0] + p[1]) + (p[2] + p[3]);
            __hip_atomic_store(slot + u.pn, __float_as_uint(t), __ATOMIC_RELAXED, __HIP_MEMORY_SCOPE_AGENT); }
        asm volatile("s_waitcnt vmcnt(0)" ::: "memory");
        unsigned* c = cnt + ((size_t)bank * 256 + u.pm) * 64;
        if (lane == 0) __hip_atomic_fetch_add(c, 1u, __ATOMIC_RELAXED, __HIP_MEMORY_SCOPE_AGENT);
        if (wid == 0) {
            for (unsigned sp = 0; sp < (1u << 17); ++sp) { if ((unsigned)__builtin_amdgcn_readfirstlane(__hip_atomic_load(c, __ATOMIC_RELAXED, __HIP_MEMORY_SCOPE_AGENT)) >= 32u) break; __builtin_amdgcn_s_sleep(2); }
        }
        asm volatile("s_waitcnt vmcnt(0) lgkmcnt(0)" ::: "memory"); __builtin_amdgcn_s_barrier(); asm volatile("" ::: "memory");
        if (lane < 32) { float tot = 0.f;
#pragma unroll
            for (int t = 0; t < 4; ++t) tot += __uint_as_float(__hip_atomic_load(slot + t, __ATOMIC_RELAXED, __HIP_MEMORY_SCOPE_AGENT));
            S[row] = 1.0f / sqrtf(tot * (1.f / 1024.f) + RMS_EPS); }
        asm volatile("s_waitcnt lgkmcnt(0)" ::: "memory"); __builtin_amdgcn_s_barrier(); asm volatile("" ::: "memory");
    }
    __device__ __forceinline__ void operator()(f32x4 (&acc)[2][2][4][2], const Unit& u, int wr, int wc, int fr, int fq) const {
        const LAS float* S = (const LAS float*)(xl + 4096);
        float part[2][4];
#pragma unroll
        for (int ai = 0; ai < 2; ++ai)
#pragma unroll
            for (int m = 0; m < 4; ++m) { float sq = 0.f;
#pragma unroll
                for (int bj = 0; bj < 2; ++bj)
#pragma unroll
                    for (int n = 0; n < 2; ++n) { const f32x4 v = acc[ai][bj][m][n]; sq += (v[0] * v[0] + v[1] * v[1]) + (v[2] * v[2] + v[3] * v[3]); }
                part[ai][m] = sq; }
        const int col0 = u.pn * BM + wc * 32 + 8 * fq;
        constexpr int NPRE = HIN_BF ? 4 : 2;
        f32x4 pre[NPRE][2][2];
#pragma unroll
        for (int m = 0; m < NPRE; ++m) { const size_t off = (size_t)(u.pm * BM + wr * 64 + m * 16 + fr) * 1024 + col0;
#pragma unroll
            for (int bj = 0; bj < 2; ++bj) {
                if (HIN_BF) { const u32x4 w = *(const u32x4*)((const bf16_t*)hres + off + bj * HALF); pre[m][bj][0] = __builtin_bit_cast(f32x4, w); }
                else { pre[m][bj][0] = *(const f32x4*)((const float*)hres + off + bj * HALF); pre[m][bj][1] = *(const f32x4*)((const float*)hres + off + bj * HALF + 4); } } }
        stats(part, u, 0, wr, wc, fr, fq);
        f32x4 g[2][2];
#pragma unroll
        for (int bj = 0; bj < 2; ++bj) { g[bj][0] = *(const f32x4*)(gpost + col0 + bj * HALF); g[bj][1] = *(const f32x4*)(gpost + col0 + bj * HALF + 4); }
#pragma unroll
        for (int ai = 0; ai < 2; ++ai)
#pragma unroll
            for (int m = 0; m < 4; ++m) { const int rl = ai * HALF + wr * 64 + m * 16 + fr; const float rs = S[rl]; const size_t off = (size_t)(u.pm * BM + rl) * 1024 + col0; float sq = 0.f;
#pragma unroll
                for (int bj = 0; bj < 2; ++bj) { f32x4 h0, h1;
                    if (HIN_BF) { u32x4 w; if (ai == 0 && m < NPRE) w = __builtin_bit_cast(u32x4, pre[m < NPRE ? m : 0][bj][0]); else w = *(const u32x4*)((const bf16_t*)hres + off + bj * HALF);
                        h0 = (f32x4){bf_lo(w.x), bf_hi(w.x), bf_lo(w.y), bf_hi(w.y)}; h1 = (f32x4){bf_lo(w.z), bf_hi(w.z), bf_lo(w.w), bf_hi(w.w)}; }
                    else { if (ai == 0 && m < NPRE) { h0 = pre[m < NPRE ? m : 0][bj][0]; h1 = pre[m < NPRE ? m : 0][bj][1]; } else { h0 = *(const f32x4*)((const float*)hres + off + bj * HALF); h1 = *(const f32x4*)((const float*)hres + off + bj * HALF + 4); } }
                    h0 += acc[ai][bj][m][0] * rs * g[bj][0]; h1 += acc[ai][bj][m][1] * rs * g[bj][1];
                    if (HOUT_BF) { u32x4 w; w.x = pk2(h0[0], h0[1]); w.y = pk2(h0[2], h0[3]); w.z = pk2(h1[0], h1[1]); w.w = pk2(h1[2], h1[3]); *(u32x4*)((bf16_t*)hout + off + bj * HALF) = w; }
                    else { *(f32x4*)((float*)hout + off + bj * HALF) = h0; *(f32x4*)((float*)hout + off + bj * HALF + 4) = h1; }
                    if (NEXT) sq += ((h0[0] * h0[0] + h0[1] * h0[1]) + (h0[2] * h0[2] + h0[3] * h0[3])) + ((h1[0] * h1[0] + h1[1] * h1[1]) + (h1[2] * h1[2] + h1[3] * h1[3])); }
                part[ai][m] = sq; }
        if (NEXT) {
            stats(part, u, 1, wr, wc, fr, fq);
            if (u.pn == 0 && wc == 0 && fq == 0) {
#pragma unroll
                for (int ai = 0; ai < 2; ++ai)
#pragma unroll
                    for (int m = 0; m < 4; ++m) { const int rl = ai * HALF + wr * 64 + m * 16 + fr; rstd_out[u.pm * BM + rl] = S[rl]; }
            }
            asm volatile("s_waitcnt lgkmcnt(0)" ::: "memory"); __builtin_amdgcn_s_barrier(); asm volatile("" ::: "memory");
        }
    }
};

template <class Epi, class Sched>
__device__ __forceinline__ void gemm_phase(LAS unsigned char* lds, const Gemm g, const Sched& S, const Epi& E, const int tid) {
    const int wid = __builtin_amdgcn_readfirstlane(tid >> 6), lane = tid & 63, wr = wid >> 2, wc = wid & 3, fr = lane & 15, fq = lane >> 4;
    const int K = g.K, nt = K / BK;
    unsigned voffA[2], voffB[2];
#pragma unroll
    for (int i = 0; i < 2; ++i) { int R, C; stage_rc(tid * 16 + i * 8192, R, C); const int Rb = Epi::PERM ? ((R & ~31) + perm32(R & 31)) : R;
        voffA[i] = (unsigned)(R * g.lda + C) * 2u; voffB[i] = (unsigned)(Rb * g.ldb + C) * 2u; }
    const size_t kstepA = g.kstepA, kstepB = g.kstepB;
    const size_t hstepA = (size_t)HALF * g.lda * 2, hstepB = (size_t)HALF * g.ldb * 2;
    const unsigned ldsw = (unsigned)wid * 1024u;
    const int aoff = lds_byte(wr * 64 + fr, fq * 8), boff = lds_byte(wc * 32 + fr, fq * 8);
#define PG8_SA(b, h) (((b) * 2 + (h)) * HTB)
#define PG8_SB(b, h) ((4 + (b) * 2 + (h)) * HTB)
#define PG8_STAGE(bufoff, gbase, voff) do { _Pragma("unroll") for (int _i = 0; _i < 2; ++_i) \
        __builtin_amdgcn_global_load_lds((const unsigned*)((const char*)(gbase) + (voff)[_i]), (LAS unsigned*)(lds + (bufoff) + ldsw + _i * 8192), 16, 0, 0); } while (0)
#define PG8_LDA(dst, b, h) do { _Pragma("unroll") for (int m = 0; m < 4; ++m) _Pragma("unroll") for (int k = 0; k < 2; ++k) dst[m][k] = *(const LAS bf16x8*)(lds + PG8_SA(b, h) + aoff + m * 2048 + k * 1024); } while (0)
#define PG8_LDB(dst, b, h) do { _Pragma("unroll") for (int n = 0; n < 2; ++n) _Pragma("unroll") for (int k = 0; k < 2; ++k) dst[n][k] = *(const LAS bf16x8*)(lds + PG8_SB(b, h) + boff + n * 2048 + k * 1024); } while (0)
#define PG8_MMA(ai, bj, At, Bt) do { __builtin_amdgcn_s_setprio(1); _Pragma("unroll") for (int m = 0; m < 4; ++m) _Pragma("unroll") for (int n = 0; n < 2; ++n) _Pragma("unroll") for (int k = 0; k < 2; ++k) \
        acc[ai][bj][m][n] = __builtin_amdgcn_mfma_f32_16x16x32_bf16(Bt[n][k], At[m][k], acc[ai][bj][m][n], 0, 0, 0); __builtin_amdgcn_s_setprio(0); } while (0)
#define PG8_WAIT_V(n) asm volatile("s_waitcnt vmcnt(" #n ")" ::: "memory")
#define PG8_WAIT_L(n) asm volatile("s_waitcnt lgkmcnt(" #n ")" ::: "memory")
#define PG8_BAR __builtin_amdgcn_s_barrier()
#define PG8_SCHED __builtin_amdgcn_sched_barrier(0)
    Unit cur, nxt; int ui = 0;
    if (!S.next(0, cur)) return;
    f32x4 acc[2][2][4][2];
#pragma unroll
    for (int a = 0; a < 2; ++a)
#pragma unroll
        for (int b = 0; b < 2; ++b)
#pragma unroll
            for (int m = 0; m < 4; ++m)
#pragma unroll
                for (int n = 0; n < 2; ++n) acc[a][b][m][n] = (f32x4){0.f, 0.f, 0.f, 0.f};
    bf16x8 At[4][2], B0[2][2], B1[2][2];
    const char* cA = g.A + cur.aoff; const char* cB = g.Bt + cur.boff;
    PG8_STAGE(PG8_SB(0, 0), cB, voffB); PG8_STAGE(PG8_SB(0, 1), cB + hstepB, voffB); PG8_STAGE(PG8_SA(0, 0), cA, voffA); PG8_STAGE(PG8_SA(0, 1), cA + hstepA, voffA);
    if (wr == 1) PG8_BAR;
    PG8_WAIT_V(2); PG8_BAR;
    PG8_STAGE(PG8_SB(1, 0), cB + kstepB, voffB); PG8_STAGE(PG8_SA(1, 0), cA + kstepA, voffA); PG8_STAGE(PG8_SB(1, 1), cB + hstepB + kstepB, voffB);
    PG8_WAIT_V(6); PG8_BAR;
    for (;;) {
        const bool has_next = S.next(ui + 1, nxt);
        const char* nA = has_next ? g.A + nxt.aoff : cA; const char* nB = has_next ? g.Bt + nxt.boff : cB;
        for (int t = 0; t < nt; t += 2) {
            const bool last = (t == nt - 2);
            const char* a1 = cA + (size_t)(t + 1) * kstepA;
            const char* a2 = last ? nA : cA + (size_t)(t + 2) * kstepA; const char* b2 = last ? nB : cB + (size_t)(t + 2) * kstepB;
            const char* a3 = a2 + kstepA; const char* b3 = b2 + kstepB;
            PG8_LDB(B0, 0, 0); PG8_LDB(B1, 0, 1); PG8_SCHED; PG8_LDA(At, 0, 0); PG8_STAGE(PG8_SA(1, 1), a1 + hstepA, voffA);
            PG8_WAIT_V(8); PG8_WAIT_L(0); PG8_BAR; PG8_MMA(0, 0, At, B0); PG8_MMA(0, 1, At, B1); PG8_BAR; PG8_SCHED;
            PG8_LDA(At, 0, 1); PG8_STAGE(PG8_SB(0, 0), b2, voffB); PG8_STAGE(PG8_SB(0, 1), b2 + hstepB, voffB); PG8_STAGE(PG8_SA(0, 0), a2, voffA);
            PG8_WAIT_V(8); PG8_WAIT_L(0); PG8_BAR; PG8_MMA(1, 0, At, B0); PG8_MMA(1, 1, At, B1); PG8_BAR; PG8_SCHED;
            PG8_LDB(B0, 1, 0); PG8_LDB(B1, 1, 1); PG8_SCHED; PG8_LDA(At, 1, 0); PG8_STAGE(PG8_SA(0, 1), a2 + hstepA, voffA);
            PG8_WAIT_V(8); PG8_WAIT_L(0); PG8_BAR; PG8_MMA(0, 0, At, B0); PG8_MMA(0, 1, At, B1); PG8_BAR; PG8_SCHED;
            PG8_LDA(At, 1, 1); PG8_STAGE(PG8_SB(1, 0), b3, voffB); PG8_STAGE(PG8_SB(1, 1), b3 + hstepB, voffB); PG8_STAGE(PG8_SA(1, 0), a3, voffA);
            PG8_WAIT_V(8); PG8_WAIT_L(0); PG8_BAR; PG8_MMA(1, 0, At, B0); PG8_MMA(1, 1, At, B1); PG8_BAR; PG8_SCHED;
        }
        if (wr == 0) PG8_BAR;
        E(acc, cur, wr, wc, fr, fq);
        if (!has_next) break;
#pragma unroll
        for (int a = 0; a < 2; ++a)
#pragma unroll
            for (int b = 0; b < 2; ++b)
#pragma unroll
                for (int m = 0; m < 4; ++m)
#pragma unroll
                    for (int n = 0; n < 2; ++n) acc[a][b][m][n] = (f32x4){0.f, 0.f, 0.f, 0.f};
        cur = nxt; cA = nA; cB = nB; ++ui;
        if (wr == 1) PG8_BAR;
    }
    PG8_WAIT_V(0);
    PG8_BAR;
#undef PG8_SA
#undef PG8_SB
#undef PG8_STAGE
#undef PG8_LDA
#undef PG8_LDB
#undef PG8_MMA
#undef PG8_WAIT_V
#undef PG8_WAIT_L
#undef PG8_BAR
#undef PG8_SCHED
}
}

namespace att {
constexpr float LOG2E = 1.4426950408889634f;
constexpr float C2 = 0.125f * LOG2E;
constexpr float THR = 8.f;
constexpr int L_KV = 0;
constexpr int L_IMP = 32768;
constexpr int L_CK = 65536;
constexpr int L_WS = 66560;
constexpr int L_OST = 68608;
constexpr int L_ISUM = 134144;
constexpr int L_MASK = 142336;
constexpr int L_MISC = 142592;

struct KVSrc { const bf16_t* k; const bf16_t* v; int pitch; int nrows; };

__device__ __forceinline__ void glds16(const void* gsrc, unsigned lds_dst) { unsigned keep;
    asm volatile("s_mov_b32 %0, m0\n\ts_mov_b32 m0, %2\n\ts_nop 0\n\tglobal_load_lds_dwordx4 %1, off\n\ts_mov_b32 m0, %0" : "=&s"(keep) : "v"(gsrc), "s"(lds_dst) : "memory"); }
__device__ __forceinline__ void glds4(const void* gsrc, unsigned lds_dst) { unsigned keep;
    asm volatile("s_mov_b32 %0, m0\n\ts_mov_b32 m0, %2\n\ts_nop 0\n\tglobal_load_lds_dword %1, off\n\ts_mov_b32 m0, %0" : "=&s"(keep) : "v"(gsrc), "s"(lds_dst) : "memory"); }
#define WAIT_BAR(N) asm volatile("s_waitcnt vmcnt(" #N ") lgkmcnt(0)\n\ts_barrier" ::: "memory")
__device__ __forceinline__ void dma_tile(LAS unsigned char* lds, int stage, const KVSrc& s, int key0, int wid, int lane) {
    const unsigned base = (unsigned)(unsigned long long)(lds + L_KV) + (unsigned)(stage * 16384 + wid * 1024);
    int kr = key0 + lane; kr = kr < 0 ? 0 : (kr >= s.nrows ? s.nrows - 1 : kr);
    const bf16_t* ks = s.k + (size_t)kr * s.pitch + wid * 8;
    glds16(ks, (unsigned)__builtin_amdgcn_readfirstlane(base));
    int vr = key0 + 16 * (wid & 3) + (lane >> 2); vr = vr < 0 ? 0 : (vr >= s.nrows ? s.nrows - 1 : vr);
    const bf16_t* vs = s.v + (size_t)vr * s.pitch + (wid >> 2) * 32 + (lane & 3) * 8;
    glds16(vs, (unsigned)__builtin_amdgcn_readfirstlane(base + 8192u));
}

__device__ __forceinline__ void qkt(f32x16& p0, f32x16& p1, const LAS unsigned char* Kslot, const bf16x8 (&qr)[4], const f32x16& c0, const f32x16& c1, int r32, int hi) {
    const LAS unsigned char* kb = Kslot + hi * 1024 + r32 * 16;
    f32x16 a, b;
    { const bf16x8 b0 = *(const LAS bf16x8*)(kb), b1 = *(const LAS bf16x8*)(kb + 512);
      a = __builtin_amdgcn_mfma_f32_32x32x16_bf16(b0, qr[0], c0, 0, 0, 0); b = __builtin_amdgcn_mfma_f32_32x32x16_bf16(b1, qr[0], c1, 0, 0, 0); }
#pragma unroll
    for (int d0 = 1; d0 < 4; ++d0) {
        const bf16x8 b0 = *(const LAS bf16x8*)(kb + d0 * 2048);
        const bf16x8 b1 = *(const LAS bf16x8*)(kb + d0 * 2048 + 512);
        a = __builtin_amdgcn_mfma_f32_32x32x16_bf16(b0, qr[d0], a, 0, 0, 0);
        b = __builtin_amdgcn_mfma_f32_32x32x16_bf16(b1, qr[d0], b, 0, 0, 0);
    }
    p0 = a; p1 = b;
}
typedef short v4i16_t __attribute__((ext_vector_type(4)));
__device__ __forceinline__ s16x4 vtr(const LAS unsigned char* p) { return __builtin_bit_cast(s16x4, __builtin_amdgcn_ds_read_tr16_b64_v4i16((LAS v4i16_t*)p)); }
__device__ __forceinline__ void pv(f32x16 (&o)[2], f32x16& lacc, const LAS unsigned char* Vslot, const bf16x8 (&pa)[4], int lane, int hi) {
    const LAS unsigned char* vp = Vslot + ((lane >> 4) & 1) * 32 + (lane & 3) * 8 + (4 * hi + ((lane & 15) >> 2)) * 64;
    const bf16x8 ones = {16256, 16256, 16256, 16256, 16256, 16256, 16256, 16256};
#pragma unroll
    for (int ks = 0; ks < 4; ++ks) {
#pragma unroll
        for (int d0 = 0; d0 < 2; ++d0) {
            const s16x4 lo = vtr(vp + d0 * 4096 + ks * 1024), hh = vtr(vp + d0 * 4096 + ks * 1024 + 512);
            const bf16x8 vf = {lo[0], lo[1], lo[2], lo[3], hh[0], hh[1], hh[2], hh[3]};
            o[d0] = __builtin_amdgcn_mfma_f32_32x32x16_bf16(pa[ks], vf, o[d0], 0, 0, 0);
        }
        lacc = __builtin_amdgcn_mfma_f32_32x32x16_bf16(pa[ks], ones, lacc, 0, 0, 0);
    }
}
__device__ __forceinline__ bf16x8 pack8(const f32x16& p, int b) {
    u32x4 w; w.x = pk2(p[b], p[b + 1]); w.y = pk2(p[b + 2], p[b + 3]); w.z = pk2(p[b + 4], p[b + 5]); w.w = pk2(p[b + 6], p[b + 7]);
    return __builtin_bit_cast(bf16x8, w);
}
__device__ __forceinline__ float max3f(float a, float b, float c) { float r; asm("v_max3_f32 %0, %1, %2, %3" : "=v"(r) : "v"(a), "v"(b), "v"(c)); return r; }
__device__ __forceinline__ float max2f(float a, float b) { float r; asm("v_max_f32_e32 %0, %1, %2" : "=v"(r) : "v"(a), "v"(b)); return r; }
__device__ __forceinline__ float rowmax(const f32x16& p0, const f32x16& p1) {
    float a = max3f(p0[0], p0[1], p1[0]), b = max3f(p0[2], p0[3], p1[1]); a = max3f(a, p1[2], p1[3]);
#pragma unroll
    for (int r = 4; r < 16; r += 4) { a = max3f(a, p0[r], p0[r + 1]); b = max3f(b, p0[r + 2], p0[r + 3]); a = max3f(a, p1[r], p1[r + 1]); b = max3f(b, p1[r + 2], p1[r + 3]); }
    const float m = max2f(a, b);
    return max2f(m, __shfl_xor(m, 32));
}
__device__ __forceinline__ void load_rowfac(f32x4 (&a)[4], LAS float* ws, float f, int r32, int hi) {
    asm volatile("" ::: "memory");
    if (hi == 0) ws[r32] = f;
    asm volatile("s_waitcnt lgkmcnt(0)" ::: "memory");
#pragma unroll
    for (int k4 = 0; k4 < 4; ++k4) a[k4] = *(const LAS f32x4*)(ws + 8 * k4 + 4 * hi);
    asm volatile("s_waitcnt lgkmcnt(0)" ::: "memory");
}

template <int MODE>
__device__ __forceinline__ void flash_sweep(LAS unsigned char* lds, const KVSrc& src, const bf16x8 (&qr)[4], f32x16 (&o)[2], f32x16& lacc,
                                            unsigned tiles, int qpos, int wq_min, int wq_max, unsigned rowmask, const float* ck2, float cq2,
                                            int wid, int lane) {
    const int r32 = lane & 31, hi = lane >> 5;
    LAS float* ws = (LAS float*)(lds + L_WS + wid * 256);
    f32x16 negm;
#pragma unroll
    for (int r = 0; r < 16; ++r) { o[0][r] = 0.f; o[1][r] = 0.f; lacc[r] = 0.f; negm[r] = 0.f; }
    float mhat = 0.f; bool fresh = true;
    unsigned ri = tiles, rc = tiles; int issued = 0, it = 0;
    const unsigned ckbase = (unsigned)(unsigned long long)(lds + L_CK);
#pragma unroll 1
    for (int k = 0; k < 3 && ri; ++k) { const int jn = __builtin_ctz(ri); ri &= ri - 1; dma_tile(lds, issued & 3, src, 64 * jn, wid, lane);
        if (MODE == 0 && wid == 0) glds4(ck2 + 64 * jn + lane, (unsigned)__builtin_amdgcn_readfirstlane(ckbase + (issued & 3) * 256)); ++issued; }
#pragma unroll 1
    while (rc) {
        const int j = __builtin_ctz(rc); rc &= rc - 1;
        const int ahead = issued - it - 1, st = it & 3;
        if (MODE == 0 && wid == 0) { if (ahead >= 2) WAIT_BAR(6); else if (ahead == 1) WAIT_BAR(3); else WAIT_BAR(0); }
        else { if (ahead >= 2) WAIT_BAR(4); else if (ahead == 1) WAIT_BAR(2); else WAIT_BAR(0); }
        if (ri) { const int jn = __builtin_ctz(ri); ri &= ri - 1; dma_tile(lds, issued & 3, src, 64 * jn, wid, lane);
            if (MODE == 0 && wid == 0) glds4(ck2 + 64 * jn + lane, (unsigned)__builtin_amdgcn_readfirstlane(ckbase + (issued & 3) * 256)); ++issued; }
        ++it;
        const int k0 = 64 * j;
        const bool skip = (k0 > wq_max) || (MODE == 2 && k0 + 63 <= wq_min - 512);
        if (!skip) {
            const LAS unsigned char* Ks = lds + L_KV + st * 16384;
            f32x16 p0, p1;
            if (MODE == 0) {
                const LAS float* ckp = (const LAS float*)(lds + L_CK + st * 256);
                const float base = cq2 - mhat; f32x16 c0v, c1v;
#pragma unroll
                for (int k4 = 0; k4 < 4; ++k4) { const f32x4 c0 = *(const LAS f32x4*)(ckp + 8 * k4 + 4 * hi), c1 = *(const LAS f32x4*)(ckp + 32 + 8 * k4 + 4 * hi);
#pragma unroll
                    for (int i = 0; i < 4; ++i) { c0v[4 * k4 + i] = base - c0[i]; c1v[4 * k4 + i] = base - c1[i]; } }
                qkt(p0, p1, Ks, qr, c0v, c1v, r32, hi);
            } else qkt(p0, p1, Ks, qr, negm, negm, r32, hi);
            const int qrel = qpos - k0 - 4 * hi;
            if (k0 + 63 > wq_min) {
                asm volatile("" ::: "memory");
#pragma unroll
                for (int r = 0; r < 16; ++r) { const int c = (r & 3) + 8 * (r >> 2); if (c > qrel) p0[r] = -INFINITY; if (c + 32 > qrel) p1[r] = -INFINITY; }
            }
            if (MODE == 2 && k0 <= wq_max - 512) {
                asm volatile("" ::: "memory");
#pragma unroll
                for (int r = 0; r < 16; ++r) { const int c = (r & 3) + 8 * (r >> 2); if (c <= qrel - 512) p0[r] = -INFINITY; if (c + 32 <= qrel - 512) p1[r] = -INFINITY; }
            }
            if (MODE == 1) {
                if (!__all((rowmask >> j) & 1u)) {
                    asm volatile("" ::: "memory");
                    const bool dead = !((rowmask >> j) & 1u);
#pragma unroll
                    for (int r = 0; r < 16; ++r) { if (dead) { p0[r] = -INFINITY; p1[r] = -INFINITY; } }
                }
            }
            const float rm = rowmax(p0, p1);
            const bool need = fresh ? (rm > -INFINITY) : (rm > THR);
            if (__any(need)) {
                asm volatile("" ::: "memory");
                const float dl = need ? (fresh ? rm : fmaxf(rm, 0.f)) : 0.f;
                const float alpha = fresh ? 1.f : __builtin_amdgcn_exp2f(-dl);
                mhat += dl; fresh = fresh && !need;
#pragma unroll
                for (int r = 0; r < 16; ++r) { p0[r] -= dl; p1[r] -= dl; negm[r] = -mhat; }
                f32x4 a[4]; load_rowfac(a, ws, alpha, r32, hi);
#pragma unroll
                for (int k4 = 0; k4 < 4; ++k4)
#pragma unroll
                    for (int i = 0; i < 4; ++i) { o[0][4 * k4 + i] *= a[k4][i]; o[1][4 * k4 + i] *= a[k4][i]; lacc[4 * k4 + i] *= a[k4][i]; }
            }
#pragma unroll
            for (int r = 0; r < 16; ++r) { p0[r] = __builtin_amdgcn_exp2f(p0[r]); p1[r] = __builtin_amdgcn_exp2f(p1[r]); }
            bf16x8 pa[4]; pa[0] = pack8(p0, 0); pa[1] = pack8(p0, 8); pa[2] = pack8(p1, 0); pa[3] = pack8(p1, 8);
            pv(o, lacc, Ks + 8192, pa, lane, hi);
        }
    }
    WAIT_BAR(0);
}

__device__ __forceinline__ void store_o(LAS unsigned char* lds, const f32x16 (&o)[2], const f32x16& fac, bf16_t* Ow, size_t pitch, int wid, int lane) {
    const int r32 = lane & 31, hi = lane >> 5;
    LAS bf16_t* stg = (LAS bf16_t*)(lds + L_OST + wid * 4096);
#pragma unroll
    for (int r = 0; r < 16; ++r) { const int orow = (r & 3) + 8 * (r >> 2) + 4 * hi;
#pragma unroll
        for (int d0 = 0; d0 < 2; ++d0) { const unsigned w = pk2(o[d0][r] * fac[r], 0.f); stg[orow * 64 + d0 * 32 + r32] = (bf16_t)(w & 0xffffu); } }
    asm volatile("s_waitcnt lgkmcnt(0)" ::: "memory");
#pragma unroll
    for (int i = 0; i < 4; ++i) { const int row = i * 8 + (lane >> 3), ch = lane & 7; const u32x4 v = *(const LAS u32x4*)(stg + row * 64 + ch * 8); *(u32x4*)(Ow + (size_t)row * pitch + ch * 8) = v; }
    asm volatile("s_waitcnt lgkmcnt(0)" ::: "memory");
}


template <bool FIRST>
__device__ __forceinline__ void acc_tile(LAS float* tl, const f32x16 (&o)[2], const f32x16& fac, int r32, int hi) {
#pragma unroll
    for (int r = 0; r < 16; ++r) { const int orow = (r & 3) + 8 * (r >> 2) + 4 * hi; const float f = fac[r];
#pragma unroll
        for (int d0 = 0; d0 < 2; ++d0) { LAS float* p = tl + orow * 64 + d0 * 32 + r32; if (FIRST) *p = o[d0][r] * f; else *p += o[d0][r] * f; } }
}
__device__ __forceinline__ void store_tile(const LAS float* tl, bf16_t* Ow, size_t pitch, int lane) {
    asm volatile("s_waitcnt lgkmcnt(0)" ::: "memory");
#pragma unroll
    for (int i = 0; i < 4; ++i) { const int row = i * 8 + (lane >> 3), ch = lane & 7; const f32x4 v0 = *(const LAS f32x4*)(tl + row * 64 + ch * 8), v1 = *(const LAS f32x4*)(tl + row * 64 + ch * 8 + 4);
        u32x4 w; w.x = pk2(v0[0], v0[1]); w.y = pk2(v0[2], v0[3]); w.z = pk2(v1[0], v1[1]); w.w = pk2(v1[2], v1[3]); *(u32x4*)(Ow + (size_t)row * pitch + ch * 8) = w; }
    asm volatile("s_waitcnt lgkmcnt(0)" ::: "memory");
}

__device__ __forceinline__ bf16x8 scale_q(bf16x8 q) {
    const u32x4 w = __builtin_bit_cast(u32x4, q); u32x4 o;
#pragma unroll
    for (int i = 0; i < 4; ++i) o[i] = pk2(bf_lo(w[i]) * C2, bf_hi(w[i]) * C2);
    return __builtin_bit_cast(bf16x8, o);
}
__device__ __forceinline__ void fox_unit(LAS unsigned char* lds, int b, int h, int qb, const bf16_t* PROJ, const float* C2buf, const float* nrm, bf16_t* AO, int wid, int lane) {
    const int r32 = lane & 31, hi = lane >> 5;
    const size_t rowbase = (size_t)b * SEQ;
    const int q0 = qb * 256 + wid * 32, qpos = q0 + r32;
    const bf16_t* Qp = PROJ + (rowbase + qpos) * NPROJ + C_FQ + h * 64;
    bf16x8 qr[4];
#pragma unroll
    for (int d0 = 0; d0 < 4; ++d0) qr[d0] = scale_q(*(const bf16x8*)(Qp + d0 * 16 + hi * 8));
    const float* ck2 = C2buf + ((size_t)b * 8 + h) * SEQ;
    float cq2 = ck2[qpos];
    asm volatile("" : "+v"(qr[0]), "+v"(qr[1]), "+v"(qr[2]), "+v"(qr[3]), "+v"(cq2));
    KVSrc src{PROJ + rowbase * NPROJ + C_FK + h * 64, PROJ + rowbase * NPROJ + C_FV + h * 64, NPROJ, SEQ};
    const int nt = 4 * qb + 4;
    unsigned tiles = nt >= 32 ? 0xffffffffu : ((1u << nt) - 1u);
    {
        const float smax = C2 * sqrtf(nrm[0]) * sqrtf(nrm[1]) * 1.01f + 0.01f;
        const int kt = lane < 32 ? lane : 31; const float dec = ck2[64 * kt + 63] - ck2[qb * 256];
        const unsigned keep = (unsigned)__ballot(dec <= 2.f * smax + 40.f);
        tiles &= keep | (0xfu << (4 * qb));
    }
    f32x16 o[2], lacc;
    flash_sweep<0>(lds, src, qr, o, lacc, tiles, qpos, q0, q0 + 31, 0u, ck2, cq2, wid, lane);
#pragma unroll
    for (int r = 0; r < 16; ++r) lacc[r] = __builtin_amdgcn_rcpf(lacc[r]);
    store_o(lds, o, lacc, AO + (rowbase + q0) * DM + h * 64, DM, wid, lane);
}

__device__ __forceinline__ void nsa_unit(LAS unsigned char* lds, int b, int g, int pb, const bf16_t* PROJ, const bf16_t* KC, const float* FG, const f32x2* ROPE, bf16_t* AO, int wid, int lane) {
    const int tid = wid * 64 + lane, r32 = lane & 31, hi = lane >> 5;
    const int hr = wid & 3, ph = wid >> 2, hd = 4 * g + hr;
    const size_t rowbase = (size_t)b * SEQ;
    const int q0 = pb * 64 + ph * 32, qpos = q0 + r32;
    LAS float* ws = (LAS float*)(lds + L_WS + wid * 256);
    const bf16_t* Qp = PROJ + (rowbase + qpos) * NPROJ + C_NQ + hd * 64;
    bf16x8 qr[4];
#pragma unroll
    for (int d0 = 0; d0 < 4; ++d0) qr[d0] = scale_q(*(const bf16x8*)(Qp + d0 * 16 + hi * 8));
    const float* gp = FG + (rowbase + qpos) * 32 + 8 + hd * 3;
    float g0 = 1.f / (1.f + __expf(-gp[0])), g1 = 1.f / (1.f + __expf(-gp[1])), g2 = 1.f / (1.f + __expf(-gp[2]));
    LAS float* tl = (LAS float*)(lds + L_OST + wid * 8192);
    {
        const bf16_t* kc = KC + ((size_t)(b * 2 + g) * 2 + 0) * 128 * 64; const bf16_t* vc = kc + 128 * 64;
        KVSrc csrc{kc, vc, 64, 128};
        dma_tile(lds, 0, csrc, 0, wid, lane); dma_tile(lds, 1, csrc, 64, wid, lane);
        WAIT_BAR(0);
        asm volatile("" : "+v"(qr[0]), "+v"(qr[1]), "+v"(qr[2]), "+v"(qr[3]), "+v"(g0), "+v"(g1), "+v"(g2));
        f32x16 zero16, lc, sc[4];
#pragma unroll
        for (int r = 0; r < 16; ++r) { zero16[r] = 0.f; lc[r] = 0.f; }
        const int nthr = ((qpos - 31) >> 4) - 4 * hi;
        qkt(sc[0], sc[1], lds + L_KV, qr, zero16, zero16, r32, hi);
        qkt(sc[2], sc[3], lds + L_KV + 16384, qr, zero16, zero16, r32, hi);
        float m = -INFINITY;
#pragma unroll
        for (int tp = 0; tp < 4; ++tp)
#pragma unroll
            for (int r = 0; r < 16; ++r) { const int n = 32 * tp + (r & 3) + 8 * (r >> 2); float v = sc[tp][r]; if (n > nthr) v = -INFINITY; sc[tp][r] = v; m = fmaxf(m, v); }
        m = fmaxf(m, __shfl_xor(m, 32));
        const float ms = (m == -INFINITY) ? 0.f : m;
        float l = 0.f;
#pragma unroll
        for (int tp = 0; tp < 4; ++tp)
#pragma unroll
            for (int r = 0; r < 16; ++r) { sc[tp][r] = __builtin_amdgcn_exp2f(sc[tp][r] - ms); l += sc[tp][r]; }
        l += __shfl_xor(l, 32);
        const float inv = l > 0.f ? 1.f / l : 0.f;
        f32x16 o[2];
#pragma unroll
        for (int r = 0; r < 16; ++r) { o[0][r] = 0.f; o[1][r] = 0.f; }
        LAS float* impw = (LAS float*)(lds + L_IMP) + ((size_t)hr * 64 + ph * 32 + r32) * 33;
        float carry = 0.f;
#pragma unroll
        for (int tp = 0; tp < 4; ++tp) {
#pragma unroll
            for (int r = 0; r < 16; ++r) sc[tp][r] *= inv;
#pragma unroll
            for (int k = 0; k < 4; ++k) { const float G = (sc[tp][4 * k] + sc[tp][4 * k + 1]) + (sc[tp][4 * k + 2] + sc[tp][4 * k + 3]); const float pe = __shfl_xor(sc[tp][4 * k + 3], 32);
                impw[8 * tp + 2 * k + hi] = G + (hi ? pe : carry); carry = pe; }
        }
#pragma unroll
        for (int ti = 0; ti < 2; ++ti) {
            bf16x8 pa[4]; pa[0] = pack8(sc[2 * ti], 0); pa[1] = pack8(sc[2 * ti], 8); pa[2] = pack8(sc[2 * ti + 1], 0); pa[3] = pack8(sc[2 * ti + 1], 8);
            pv(o, lc, lds + L_KV + ti * 16384 + 8192, pa, lane, hi);
        }
        f32x4 a[4]; load_rowfac(a, ws, g0, r32, hi); f32x16 fac;
#pragma unroll
        for (int r = 0; r < 16; ++r) fac[r] = a[r >> 2][r & 3];
        acc_tile<true>(tl, o, fac, r32, hi);
    }
    __syncthreads();
    {
        const int pos = tid >> 3, jq = tid & 7;
        const LAS float* ip = (const LAS float*)(lds + L_IMP) + (size_t)pos * 33 + 4 * jq;
        f32x4 v;
#pragma unroll
        for (int i = 0; i < 4; ++i) v[i] = ((ip[i] + ip[64 * 33 + i]) + ip[2 * 64 * 33 + i]) + ip[3 * 64 * 33 + i];
#pragma unroll
        for (int i = 0; i < 4; ++i) { const int jj = 4 * jq + i; float x = v[i];
            if (jj == pb) x = 2.0e4f; else if (jj == 0 || jj == pb - 1) x = 1.0e4f;
            if (jj > pb) x = -1.0f; v[i] = x; }
        *(LAS f32x4*)((LAS float*)(lds + L_ISUM) + (size_t)pos * 32 + 4 * jq) = v;
    }
    __syncthreads();
    {
        const int pos = tid >> 3, jq = tid & 7;
        const LAS float* sp = (const LAS float*)(lds + L_ISUM) + (size_t)pos * 32;
        const f32x4 mine = *(const LAS f32x4*)(sp + 4 * jq);
        int rk0 = 0, rk1 = 0, rk2 = 0, rk3 = 0; const int j0 = 4 * jq;
#pragma unroll 4
        for (int c = 0; c < 32; ++c) { const float a = sp[c];
            rk0 += (a > mine[0] || (a == mine[0] && c < j0)) ? 1 : 0; rk1 += (a > mine[1] || (a == mine[1] && c < j0 + 1)) ? 1 : 0;
            rk2 += (a > mine[2] || (a == mine[2] && c < j0 + 2)) ? 1 : 0; rk3 += (a > mine[3] || (a == mine[3] && c < j0 + 3)) ? 1 : 0; }
        unsigned bits = (rk0 < 16 ? 1u : 0u) | (rk1 < 16 ? 2u : 0u) | (rk2 < 16 ? 4u : 0u) | (rk3 < 16 ? 8u : 0u); bits <<= j0;
        bits |= __shfl_xor(bits, 1); bits |= __shfl_xor(bits, 2); bits |= __shfl_xor(bits, 4);
        if (jq == 0) ((LAS unsigned*)(lds + L_MASK))[pos] = bits;
    }
    __syncthreads();
    {
        const f32x2* rp = ROPE + (size_t)qpos * 32;
#pragma unroll
        for (int d0 = 0; d0 < 4; ++d0) {
            const u32x4 w = __builtin_bit_cast(u32x4, qr[d0]); u32x4 wo;
#pragma unroll
            for (int i = 0; i < 4; ++i) { const f32x2 cs = rp[8 * d0 + 4 * hi + i]; const float x1 = bf_lo(w[i]), x2 = bf_hi(w[i]);
                wo[i] = pk2(x1 * cs.x - x2 * cs.y, x2 * cs.x + x1 * cs.y); }
            qr[d0] = __builtin_bit_cast(bf16x8, wo);
        }
        asm volatile("" : "+v"(qr[0]), "+v"(qr[1]), "+v"(qr[2]), "+v"(qr[3]));
    }
    const unsigned upto = pb >= 31 ? 0xffffffffu : ((1u << (pb + 1)) - 1u);
#ifndef NO_SLC
    {
        const LAS unsigned* mk = (const LAS unsigned*)(lds + L_MASK);
        const unsigned rowmask = mk[ph * 32 + r32] & upto;
        unsigned un = mk[lane];
#pragma unroll
        for (int o_ = 1; o_ < 64; o_ <<= 1) un |= __shfl_xor(un, o_);
        un = (unsigned)__builtin_amdgcn_readfirstlane(un) & upto;
        KVSrc src{PROJ + rowbase * NPROJ + C_KS + g * 64, PROJ + rowbase * NPROJ + C_VS + g * 64, NPROJ, SEQ};
        f32x16 o[2], lacc;
        flash_sweep<1>(lds, src, qr, o, lacc, un, qpos, q0, q0 + 31, rowmask, nullptr, 0.f, wid, lane);
        f32x4 a[4]; load_rowfac(a, ws, g1, r32, hi);
#pragma unroll
        for (int r = 0; r < 16; ++r) lacc[r] = lacc[r] > 0.f ? a[r >> 2][r & 3] * __builtin_amdgcn_rcpf(lacc[r]) : 0.f;
        acc_tile<false>(tl, o, lacc, r32, hi);
    }
#endif
#ifndef NO_WIN
    {
        const int tlo = pb - 8 < 0 ? 0 : pb - 8;
        const unsigned tiles = upto & ~((1u << tlo) - 1u);
        KVSrc src{PROJ + rowbase * NPROJ + C_KW + g * 64, PROJ + rowbase * NPROJ + C_VW + g * 64, NPROJ, SEQ};
        f32x16 o[2], lacc;
        flash_sweep<2>(lds, src, qr, o, lacc, tiles, qpos, q0, q0 + 31, 0u, nullptr, 0.f, wid, lane);
        f32x4 a[4]; load_rowfac(a, ws, g2, r32, hi);
#pragma unroll
        for (int r = 0; r < 16; ++r) lacc[r] = lacc[r] > 0.f ? a[r >> 2][r & 3] * __builtin_amdgcn_rcpf(lacc[r]) : 0.f;
        acc_tile<false>(tl, o, lacc, r32, hi);
    }
#endif
    store_tile(tl, AO + (rowbase + q0) * DM + 512 + hd * 64, DM, lane);
}
}

constexpr int NWAVES = 8;
constexpr int LDS_BYTES = 147456;
constexpr int NPHASE = 16;

struct Args {
    const float* in[23]; float* out; unsigned char* ws; int ph_lo, ph_hi;
};

__device__ __forceinline__ int win_src(int j) {
    if (j < 1536) return j;
    if (j < 2048) { const int t = j - 1536, h = t >> 6, jj = t & 63; return 1544 + h * 64 + (jj >> 1) + 32 * (jj & 1); }
    if (j < 2176) return 2056 + (j - 2048);
    if (j < 2304) return 2184 + (j - 2176);
    if (j < 2432) { const int t = j - 2304, h = t >> 6, jj = t & 63; return 2312 + h * 64 + (jj >> 1) + 32 * (jj & 1); }
    if (j < 2560) return 2440 + (j - 2432);
    if (j < 2688) { const int t = j - 2560, h = t >> 6, jj = t & 63; return 2568 + h * 64 + (jj >> 1) + 32 * (jj & 1); }
    if (j < 2816) return 2696 + (j - 2688);
    if (j < 2824) return 1536 + (j - 2816);
    if (j < 2848) return j;
    return -1;
}
template <bool MAPPED>
__device__ __forceinline__ void transpose_item(const float* W, int K, int N, bf16_t* WT, int ndest, LAS float* scr, int item, int lane, const float* kgain = nullptr) {
    const int nblk = ndest / 32, kb = item / nblk, nb = item % nblk, k0 = 64 * kb, n0 = 32 * nb;
    const int sc = MAPPED ? win_src(n0 + (lane & 31)) : (n0 + (lane & 31));
#pragma unroll 8
    for (int i = 0; i < 32; ++i) { const int kk = 2 * i + (lane >> 5); float w = sc >= 0 ? W[(size_t)(k0 + kk) * N + sc] : 0.f; if (kgain) w *= kgain[k0 + kk]; scr[kk * 33 + (lane & 31)] = w; }
    asm volatile("s_waitcnt lgkmcnt(0)" ::: "memory");
    const int c = lane & 7;
#pragma unroll
    for (int j = 0; j < 4; ++j) { const int n = (lane >> 3) + 8 * j; const LAS float* s = scr + (8 * c) * 33 + n;
        u32x4 o; o.x = pk2(s[0 * 33], s[1 * 33]); o.y = pk2(s[2 * 33], s[3 * 33]); o.z = pk2(s[4 * 33], s[5 * 33]); o.w = pk2(s[6 * 33], s[7 * 33]);
        *(u32x4*)(WT + (size_t)(n0 + n) * K + k0 + 8 * c) = o; }
    asm volatile("s_waitcnt lgkmcnt(0)" ::: "memory");
}
template <int R>
__device__ __forceinline__ void rms_rows_to_bf16(const float* x0, const float* g, bf16_t* o0, int lane) {
    f32x4 v[R][4];
#pragma unroll
    for (int r = 0; r < R; ++r) { const f32x4* xr = (const f32x4*)(x0 + (size_t)r * 1024) + lane;
#pragma unroll
        for (int j = 0; j < 4; ++j) v[r][j] = xr[64 * j]; }
    const f32x4* gr = (const f32x4*)g + lane; f32x4 gg[4];
#pragma unroll
    for (int j = 0; j < 4; ++j) gg[j] = gr[64 * j];
#pragma unroll
    for (int r = 0; r < R; ++r) { float s = 0.f;
#pragma unroll
        for (int j = 0; j < 4; ++j) s += (v[r][j].x * v[r][j].x + v[r][j].y * v[r][j].y) + (v[r][j].z * v[r][j].z + v[r][j].w * v[r][j].w);
        const float rstd = 1.0f / sqrtf(wave_sum(s) * (1.f / 1024.f) + RMS_EPS);
        u32x2* o8 = (u32x2*)(o0 + (size_t)r * 1024) + lane;
#pragma unroll
        for (int j = 0; j < 4; ++j) { u32x2 w; w.x = pk2(v[r][j].x * rstd * gg[j].x, v[r][j].y * rstd * gg[j].y); w.y = pk2(v[r][j].z * rstd * gg[j].z, v[r][j].w * rstd * gg[j].w); o8[64 * j] = w; } }
}
template <bool NEXT, int R, bool HIN_BF, bool HOUT_BF>
__device__ __forceinline__ void residual_rows(const void* hres, const bf16_t* y, const float* gpost, void* hout, float* rstd_out, int lane) {
    u32x2 yw[R][4]; f32x4 hv[R][4];
#pragma unroll
    for (int r = 0; r < R; ++r) { const u32x2* yr = (const u32x2*)(y + (size_t)r * 1024) + lane;
#pragma unroll
        for (int j = 0; j < 4; ++j) yw[r][j] = yr[64 * j];
        if (HIN_BF) { const u32x2* hr = (const u32x2*)((const bf16_t*)hres + (size_t)r * 1024) + lane;
#pragma unroll
            for (int j = 0; j < 4; ++j) { const u32x2 w = hr[64 * j]; hv[r][j] = (f32x4){bf_lo(w.x), bf_hi(w.x), bf_lo(w.y), bf_hi(w.y)}; } }
        else { const f32x4* hr = (const f32x4*)((const float*)hres + (size_t)r * 1024) + lane;
#pragma unroll
            for (int j = 0; j < 4; ++j) hv[r][j] = hr[64 * j]; } }
    const f32x4* gp = (const f32x4*)gpost + lane; f32x4 g1[4];
#pragma unroll
    for (int j = 0; j < 4; ++j) g1[j] = gp[64 * j];
#pragma unroll
    for (int r = 0; r < R; ++r) { f32x4 yv[4]; float s = 0.f;
#pragma unroll
        for (int j = 0; j < 4; ++j) { const u32x2 w = yw[r][j]; yv[j] = (f32x4){bf_lo(w.x), bf_hi(w.x), bf_lo(w.y), bf_hi(w.y)}; s += (yv[j].x * yv[j].x + yv[j].y * yv[j].y) + (yv[j].z * yv[j].z + yv[j].w * yv[j].w); }
        const float rstd = 1.0f / sqrtf(wave_sum(s) * (1.f / 1024.f) + RMS_EPS); float s2 = 0.f;
#pragma unroll
        for (int j = 0; j < 4; ++j) { const f32x4 h = hv[r][j] + yv[j] * rstd * g1[j]; hv[r][j] = h; s2 += (h.x * h.x + h.y * h.y) + (h.z * h.z + h.w * h.w); }
        if (HOUT_BF) { u32x2* ho = (u32x2*)((bf16_t*)hout + (size_t)r * 1024) + lane;
#pragma unroll
            for (int j = 0; j < 4; ++j) { const f32x4 h = hv[r][j]; u32x2 w; w.x = pk2(h.x, h.y); w.y = pk2(h.z, h.w); ho[64 * j] = w; } }
        else { f32x4* ho = (f32x4*)((float*)hout + (size_t)r * 1024) + lane;
#pragma unroll
            for (int j = 0; j < 4; ++j) ho[64 * j] = hv[r][j]; }
        if (NEXT) { const float r2 = 1.0f / sqrtf(wave_sum(s2) * (1.f / 1024.f) + RMS_EPS); if (lane == 0) rstd_out[r] = r2;
        } }
}

struct KvMemOrder {
    int G, c;
    __device__ bool next(int i, pg8::Unit& u) const {
        const int L = i * G + c; if (L >= 256) return false;
        if (L < 128) { u.z = 0; u.pm = L >> 2; u.pn = L & 3; u.aoff = (size_t)u.pm * 256 * 1024 * 2; u.boff = (size_t)u.pn * 256 * 1024 * 2; u.coff = (size_t)u.pm * 256 * 1024 + u.pn * 256; }
        else { const int t = L - 128; u.z = 1; u.pm = t >> 5; u.pn = t & 31;
            u.aoff = (size_t)(WS_WXKV - WS_MN) + (size_t)(1024 + u.pm * 256) * 1024 * 2;
            u.boff = (size_t)(WS_MN - WS_WXKV) + (size_t)u.pn * 256 * 1024 * 2;
            u.coff = (size_t)(WS_VT - WS_KX) / 2 + (size_t)u.pm * 256 * 8192 + u.pn * 256; }
        return true;
    }
};
struct EpiKvMem {
    static constexpr bool PERM = true;
    bf16_t* O;
    __device__ __forceinline__ void operator()(const f32x4 (&acc)[2][2][4][2], const pg8::Unit& u, int wr, int wc, int fr, int fq) const {
        pg8::EpiBf16<0> e{O, u.z ? (size_t)8192 : (size_t)1024}; e(acc, u, wr, wc, fr, fq);
    }
};
struct CmpOrder {
    int G, c;
    __device__ bool next(int i, pg8::Unit& u) const {
        const int L = i * G + c; if (L >= 64) return false;
        u.z = L >> 4; u.pm = L & 15; u.pn = 0; const int g = u.z >> 1, kv = u.z & 1;
        u.aoff = ((size_t)u.pm * 256 * 16 * NPROJ + (kv ? C_VC : C_KC) + g * 64) * 2;
        u.boff = (size_t)kv * 256 * 1024 * 2;
        u.coff = (size_t)u.z * 4096 * 256 + (size_t)u.pm * 256 * 256;
        return true;
    }
};
struct XAttnOrder {
    int G, c; bool sv;
    __device__ bool next(int i, pg8::Unit& u) const {
        const int L = i * G + c; if (L >= 1024) return false;
        const int b = L >> 5, h = (L >> 3) & 3, rp = L & 7; u.z = 0; u.pm = b * 8 + rp; u.pn = h;
        u.aoff = ((size_t)u.pm * 256 * 1024 + h * 256) * 2;
        u.boff = sv ? ((size_t)h * 256 * 8192 + b * 256) * 2 : ((size_t)b * 256 * 1024 + h * 256) * 2;
        u.coff = (size_t)u.pm * 256 * 1024 + h * 256;
        return true;
    }
};


#define XB_TMO      128
#define XB_XCNT(j)  (256  + 64 * (j))
#define XB_XSUB(j)  (1280 + 64 * (j))
#define XB_XGEN(j)  (2304 + 64 * (j))
#define XB_TOP      3328
#define XB_TOPGEN   3392
#define XCD_BAR_WORDS 3456
#define XB_SPIN_CAP (1u << 18)
__device__ __forceinline__ unsigned xb_ld(unsigned* p)              { return __hip_atomic_load(p, __ATOMIC_RELAXED, __HIP_MEMORY_SCOPE_AGENT); }
__device__ __forceinline__ unsigned xb_add(unsigned* p, unsigned v) { return __hip_atomic_fetch_add(p, v, __ATOMIC_RELAXED, __HIP_MEMORY_SCOPE_AGENT); }
__device__ __forceinline__ unsigned xb_xcc_id() { return (unsigned)__builtin_amdgcn_s_getreg((3 << 11) | 20) & 0xFu; }
#define XB_SPIN(cond, bar) do { unsigned _sp = 0; while (cond) { __builtin_amdgcn_s_sleep(1); \
    if ((++_sp & 255u) == 0u) { if (xb_ld(&(bar)[XB_TMO])) break; if (_sp > XB_SPIN_CAP) { atomicAdd(&(bar)[XB_TMO], 1u); break; } } } } while (0)
__device__ __forceinline__ void xcd_barrier_complete(unsigned* bar, unsigned x, unsigned& nloc, unsigned& nx) {
    const unsigned G = gridDim.x * gridDim.y * gridDim.z;
    unsigned sum, cnt, mine, sp = 0u;
    for (;;) {
        sum = 0u; cnt = 0u; mine = 0u;
#pragma unroll
        for (unsigned j = 0; j < 16; ++j) { const unsigned c = xb_ld(&bar[XB_XCNT(j)]); sum += c; cnt += (c > 0u) ? 1u : 0u; mine = (j == x) ? c : mine; }
        if (sum == G) break;
        __builtin_amdgcn_s_sleep(1);
        if ((++sp & 255u) == 0u) { if (xb_ld(&bar[XB_TMO])) break; if (sp > XB_SPIN_CAP) { atomicAdd(&bar[XB_TMO], 1u); break; } }
    }
    nloc = mine > 0u ? mine : 1u; nx = cnt > 0u ? cnt : 1u;
}
__device__ __forceinline__ void xcd_barrier(unsigned* bar, unsigned x, volatile LAS unsigned* st, int tid) {
    asm volatile("s_waitcnt vmcnt(0)" ::: "memory");
    __syncthreads();
    if (tid == 0) {
        __builtin_amdgcn_s_waitcnt(0);
        unsigned nloc = st[0], nx = st[1];
        if (nloc == 0u) { xcd_barrier_complete(bar, x, nloc, nx); st[0] = nloc; st[1] = nx; }
        const unsigned old = xb_add(&bar[XB_XSUB(x)], 1u);
        const unsigned gen = old / nloc;
        if (old + 1u == (gen + 1u) * nloc) {
            __builtin_amdgcn_fence(__ATOMIC_RELEASE, "agent");
            asm volatile("s_waitcnt vmcnt(0)" ::: "memory");
            const unsigned og = xb_add(&bar[XB_TOP], 1u);
            const unsigned tg = og / nx;
            if (og + 1u == (tg + 1u) * nx) xb_add(&bar[XB_TOPGEN], 1u);
            else XB_SPIN(xb_ld(&bar[XB_TOPGEN]) == tg, bar);
            __builtin_amdgcn_fence(__ATOMIC_ACQUIRE, "agent");
            xb_add(&bar[XB_XGEN(x)], 1u);
            asm volatile("s_waitcnt vmcnt(0)" ::: "memory");
        } else {
            XB_SPIN(xb_ld(&bar[XB_XGEN(x)]) == gen, bar);
            __builtin_amdgcn_fence(__ATOMIC_ACQUIRE, "agent");
            asm volatile("s_waitcnt vmcnt(0)" ::: "memory");
        }
    }
    __syncthreads();
}
constexpr int CW_BAR = 4096;
constexpr int LDS_BARST = 143360;

__global__ void __launch_bounds__(NWAVES * 64, 2) layer_fwd(Args args) {
    extern __shared__ __attribute__((aligned(16))) unsigned char lds_raw[];
    LAS unsigned char* lds = (LAS unsigned char*)lds_raw;
    int wave_s = __builtin_amdgcn_readfirstlane((int)threadIdx.x >> 6);
    const int G = gridDim.x, bx = blockIdx.x;
    volatile LAS unsigned* barst = (volatile LAS unsigned*)(lds + LDS_BARST);
    unsigned xcc = 0u;
    if (args.ph_hi - args.ph_lo > 1) {
        if (threadIdx.x == 0) { barst[0] = 0u; barst[1] = 0u; }
        xcc = xb_xcc_id();
        if (threadIdx.x == 0) (void)xb_add((unsigned*)(args.ws + WS_CTL) + CW_BAR + XB_XCNT(xcc), 1u);
        __syncthreads();
    }
#define PHASE_IDS asm volatile("" : "+s"(wave_s)); auto kp_ = __builtin_amdgcn_kernarg_segment_ptr(); asm volatile("" : "+s"(kp_)); const Args* ap = (const Args*)kp_; unsigned char* const ws = ap->ws; (void)ws; const int wave = wave_s, lane = (int)__builtin_amdgcn_mbcnt_hi(~0u, __builtin_amdgcn_mbcnt_lo(~0u, 0u)), tid = wave * 64 + lane, gw = bx * NWAVES + wave, NGW = G * NWAVES; (void)tid; (void)gw; (void)NGW; (void)lane

#define INP(k) (ap->in[k])
#define x_ INP(0)
#define mem_ INP(1)
#define g_mix_pre INP(2)
#define w_in INP(3)
#define b_forget INP(4)
#define w_ck1 INP(5)
#define w_ck2 INP(6)
#define w_cv1 INP(7)
#define w_cv2 INP(8)
#define pe_k INP(9)
#define pe_v INP(10)
#define w_mix_out INP(11)
#define g_mix_post INP(12)
#define g_x_pre INP(13)
#define g_mem INP(14)
#define w_xq INP(15)
#define w_xkv INP(16)
#define w_xo INP(17)
#define g_x_post INP(18)
#define g_mlp_pre INP(19)
#define w_up INP(20)
#define w_down INP(21)
#define g_mlp_post INP(22)
#define OUTP (ap->out)
#define ctl ((unsigned*)(ws + WS_CTL))
#define WinT ((bf16_t*)(ws + WS_WIN))
#define WoutT ((bf16_t*)(ws + WS_WOUT))
#define WxqT ((bf16_t*)(ws + WS_WXQ))
#define WxkvT ((bf16_t*)(ws + WS_WXKV))
#define WxoT ((bf16_t*)(ws + WS_WXO))
#define WupT ((bf16_t*)(ws + WS_WUP))
#define WdnT ((bf16_t*)(ws + WS_WDN))
#define Wc1T ((bf16_t*)(ws + WS_WC1))
#define ROPE ((f32x2*)(ws + WS_ROPE))
#define BIAS1 ((float*)(ws + WS_BIAS1))
#define FG ((float*)(ws + WS_FG))
#define C2B ((float*)(ws + WS_C2))
#define Y ((float*)(ws + WS_Y))
#define KC ((bf16_t*)(ws + WS_KC))
#define MN ((bf16_t*)(ws + WS_MN))
#define KX ((bf16_t*)(ws + WS_KX))
#define VT ((bf16_t*)(ws + WS_VT))
#define NB ((bf16_t*)(ws + WS_N))
#define GB ((bf16_t*)(ws + WS_G))
#define AO ((bf16_t*)(ws + WS_AO))
#define PROJ ((bf16_t*)(ws + WS_PROJ))
#define QX ((bf16_t*)(ws + WS_QX))
#define SB ((float*)(ws + WS_S))
#define PB ((bf16_t*)(ws + WS_AO))
#define XOIN ((bf16_t*)(ws + WS_QX))
#define UB ((bf16_t*)(ws + WS_U))
#define H1B ((bf16_t*)(ws + WS_S))
#define RSTD2 ((float*)(ws + WS_Y))
#define RSTD3 ((float*)(ws + WS_Y + MiB))
#define XSB ((float*)(ws + WS_Y + 2 * MiB))
    const int lo = args.ph_lo, hi_ph = args.ph_hi;
#ifndef PHASE_MASK
#define PHASE_MASK 0xffff
#endif
#define IN(k) (((PHASE_MASK >> (k)) & 1) && lo <= (k) && (k) < hi_ph)
#define SEAM(k) do { if (lo <= (k) && (k) + (((k) == 5 || (k) == 8 || (k) == 11) ? 2 : 1) < hi_ph) { if ((k) == 0) cg::this_grid().sync(); else { PHASE_IDS; xcd_barrier(ctl + CW_BAR, xcc, barst, tid); } } } while (0)

    if (IN(0)) { PHASE_IDS;
        LAS float* scr = (LAS float*)(lds + wave * 16384);
        constexpr int I_IN = 16 * 96, I_SQ = 16 * 32, I_KV = 16 * 64, I_UP = 16 * 128, I_DN = 64 * 32, I_C1 = 16 * 4;
        constexpr int NITEMS = I_IN + 3 * I_SQ + I_KV + I_UP + I_DN + 4 * I_C1;
        for (int it = gw; it < NITEMS; it += NGW) {
            int r = it;
            if (r < I_IN) { transpose_item<true>(w_in, 1024, 2848, WinT, 3072, scr, r, lane); continue; } r -= I_IN;
            if (r < I_SQ) { transpose_item<false>(w_mix_out, 1024, 1024, WoutT, 1024, scr, r, lane); continue; } r -= I_SQ;
            if (r < I_SQ) { transpose_item<false>(w_xq, 1024, 1024, WxqT, 1024, scr, r, lane, g_x_pre); continue; } r -= I_SQ;
            if (r < I_SQ) { transpose_item<false>(w_xo, 1024, 1024, WxoT, 1024, scr, r, lane); continue; } r -= I_SQ;
            if (r < I_KV) { transpose_item<false>(w_xkv, 1024, 2048, WxkvT, 2048, scr, r, lane); continue; } r -= I_KV;
            if (r < I_UP) { transpose_item<false>(w_up, 1024, 4096, WupT, 4096, scr, r, lane, g_mlp_pre); continue; } r -= I_UP;
            if (r < I_DN) { transpose_item<false>(w_down, 4096, 1024, WdnT, 1024, scr, r, lane); continue; } r -= I_DN;
            { const int q = r / I_C1, rr = r % I_C1, kv = q >> 1, a = q & 1; const float* W1 = kv ? w_cv1 : w_ck1;
              transpose_item<false>(W1 + (size_t)a * 1024 * 128, 1024, 128, Wc1T + (size_t)kv * 256 * 1024 + (size_t)a * 128 * 1024, 128, scr, rr, lane); }
        }
        for (int m = gw * 4; m < MTOK; m += NGW * 4) rms_rows_to_bf16<4>(x_ + (size_t)m * DM, g_mix_pre, NB + (size_t)m * DM, lane);
        for (int m = gw * 4; m < MMEM; m += NGW * 4) rms_rows_to_bf16<4>(mem_ + (size_t)m * DM, g_mem, MN + (size_t)m * DM, lane);
        for (int i = bx * 512 + tid; i < SEQ * 32; i += G * 512) { const int pos = i >> 5, k = i & 31;
            const float inv = powf(10000.0f, -(float)k / 32.0f); const float ang = (float)pos * inv; float sn, cs; sincosf(ang, &sn, &cs); ROPE[i] = (f32x2){cs, sn}; }
        for (int o_ = gw; o_ < 256; o_ += NGW) { const int kv = o_ >> 7, c = o_ & 127; const float* W1 = kv ? w_cv1 : w_ck1; const float* pe = kv ? pe_v : pe_k; float s = 0.f;
            for (int kk = lane; kk < 2048; kk += 64) s += pe[kk] * W1[(size_t)kk * 128 + c];
            s = wave_sum(s); if (lane == 0) BIAS1[o_] = s; }
    }
    SEAM(0);
    if (IN(1)) { PHASE_IDS;
        { pg8::Gemm g{(const char*)NB, (const char*)WinT, 1024, 1024, 128, 128, 1024}; pg8::StaticOrder S; S.init(MTOK, NPROJ, G, bx, 1024, 1024, NPROJ);
          pg8::EpiProj E{PROJ, FG}; pg8::gemm_phase(lds, g, S, E, tid); }
        { pg8::Gemm g{(const char*)MN, (const char*)WxkvT, 1024, 1024, 128, 128, 1024}; KvMemOrder S{G, bx}; EpiKvMem E{KX}; pg8::gemm_phase(lds, g, S, E, tid); }
    }
    SEAM(1);
    if (IN(2)) { PHASE_IDS;
        const int nb = G > 64 ? 64 : 0;
        if (bx < 64 || nb == 0) {
            pg8::Gemm g{(const char*)PROJ, (const char*)Wc1T, 16 * NPROJ, 1024, NPROJ * 2, 128, 1024}; CmpOrder S{nb ? 64 : G, bx}; pg8::EpiF32 E{Y, 256, 1.0f};
            pg8::gemm_phase(lds, g, S, E, tid);
        }
        if (bx >= nb) {
            const int egw = (bx - nb) * NWAVES + wave, ENGW = (G - nb) * NWAVES;
            for (int s = egw; s < BATCH * 8; s += ENGW) { const int b = s >> 3, h = s & 7; const float bf = b_forget[h];
                const float* fp = FG + ((size_t)b * SEQ + lane * 32) * 32 + h; float v[32]; float run = 0.f;
#pragma unroll
                for (int i = 0; i < 32; ++i) { const float z = fp[(size_t)i * 32] + bf; const float ls = fminf(z, 0.f) - log1pf(expf(-fabsf(z))); run += ls; v[i] = run; }
                float incl = run;
#pragma unroll
                for (int o_ = 1; o_ < 64; o_ <<= 1) { const float t = __shfl_up(incl, o_); if (lane >= o_) incl += t; }
                const float excl = incl - run; float* cp = C2B + (size_t)s * SEQ + lane * 32;
#pragma unroll
                for (int i = 0; i < 32; ++i) cp[i] = (v[i] + excl) * att::LOG2E; }
            for (int tsk = egw; tsk < BATCH * 8 * 32; tsk += ENGW) { const int bh = tsk >> 5, ch = tsk & 31, b = bh >> 3, h = bh & 7;
                const bf16_t* base = PROJ + ((size_t)b * SEQ + ch * 64 + (lane >> 3)) * NPROJ + h * 64 + (lane & 7) * 8; float mq = 0.f, mk = 0.f;
#pragma unroll
                for (int p = 0; p < 8; ++p) { const u32x4 wq = *(const u32x4*)(base + (size_t)p * 8 * NPROJ + C_FQ), wk = *(const u32x4*)(base + (size_t)p * 8 * NPROJ + C_FK); float sq = 0.f, sk = 0.f;
#pragma unroll
                    for (int i = 0; i < 4; ++i) { const float a = bf_lo(wq[i]), c = bf_hi(wq[i]), d = bf_lo(wk[i]), e = bf_hi(wk[i]); sq += a * a + c * c; sk += d * d + e * e; }
                    sq += __shfl_xor(sq, 1); sq += __shfl_xor(sq, 2); sq += __shfl_xor(sq, 4); sk += __shfl_xor(sk, 1); sk += __shfl_xor(sk, 2); sk += __shfl_xor(sk, 4);
                    mq = fmaxf(mq, sq); mk = fmaxf(mk, sk); }
                mq = wave_max(mq); mk = wave_max(mk);
                if (lane == 0) { atomicMax(&ctl[CW_NORM + 2 * bh], __float_as_uint(mq)); atomicMax(&ctl[CW_NORM + 2 * bh + 1], __float_as_uint(mk)); } }
            for (int m = egw; m < MTOK; m += ENGW) { const int pos = m & (SEQ - 1); const int cl = 4 * (lane & 31);
                bf16_t* p = PROJ + (size_t)m * NPROJ + (lane < 32 ? C_KS : C_KW) + cl; const int i0 = (cl & 63) >> 1;
                const u32x2 w = *(const u32x2*)p; const f32x2 cs0 = ROPE[pos * 32 + i0], cs1 = ROPE[pos * 32 + i0 + 1]; u32x2 o;
                { const float x1 = bf_lo(w.x), x2 = bf_hi(w.x); o.x = pk2(x1 * cs0.x - x2 * cs0.y, x2 * cs0.x + x1 * cs0.y); }
                { const float x1 = bf_lo(w.y), x2 = bf_hi(w.y); o.y = pk2(x1 * cs1.x - x2 * cs1.y, x2 * cs1.x + x1 * cs1.y); }
                *(u32x2*)p = o; }
        }
    }
    SEAM(2);
    if (IN(3)) { PHASE_IDS;
        LAS float* hs = (LAS float*)(lds + wave * 512);
        for (int idx = gw; idx < 4 * BATCH * 128; idx += NGW) { const int z = idx >> 12, rem = idx & 4095, b = rem >> 7, n = rem & 127, g = z >> 1, kv = z & 1;
            bf16_t* dst = KC + (((size_t)(b * 2 + g) * 2 + kv) * 128 + n) * 64;
            if (n == 127) { dst[lane] = 0; continue; }
            const float* y0 = Y + ((size_t)z * 4096 + b * 128 + n) * 256; const float* y1 = y0 + 256 + 128;
#pragma unroll
            for (int q = 0; q < 2; ++q) { const int c = lane + 64 * q; const float a = y0[c] + y1[c] + BIAS1[kv * 128 + c]; hs[c] = a / (1.f + __expf(-a)); }
            asm volatile("s_waitcnt lgkmcnt(0)" ::: "memory");
            const float* W2 = kv ? w_cv2 : w_ck2; const int js = kv ? lane : ((lane >> 1) + 32 * (lane & 1)); float acc = 0.f;
#pragma unroll 8
            for (int c = 0; c < 128; ++c) acc += hs[c] * W2[c * 64 + js];
            dst[lane] = (bf16_t)(pk2(acc, 0.f) & 0xffffu);
            asm volatile("s_waitcnt lgkmcnt(0)" ::: "memory"); }
    }
    SEAM(3);
    if (IN(4)) { PHASE_IDS;
        LAS int* qw = (LAS int*)(lds + att::L_MISC);
        const int myq = (int)(xb_xcc_id() & 7u);
        for (int qi = 0; qi < 8; ++qi) {
            const int q = (myq + qi) & 7;
            for (;;) {
                if (tid == 0) qw[0] = (int)atomicAdd(&ctl[CW_QUEUE + 64 * q], 1u);
                __syncthreads();
                const int u = qw[0];
                __syncthreads();
                if (u >= 512) break;
                const int b = q + 8 * (u >> 7), r = u & 127;
                if (r < 64) att::nsa_unit(lds, b, r & 1, 31 - (r >> 1), PROJ, KC, FG, ROPE, AO, wave, lane);
                else { const int v = r - 64; att::fox_unit(lds, b, v & 7, 7 - (v >> 3), PROJ, C2B, (const float*)(ctl + CW_NORM + 2 * (b * 8 + (v & 7))), AO, wave, lane); }
            }
        }
    }
    SEAM(4);
    if (IN(5)) { PHASE_IDS; pg8::Gemm g{(const char*)AO, (const char*)WoutT, 1024, 1024, 128, 128, 1024}; pg8::StaticOrder S; S.init(MTOK, 1024, G, bx, 1024, 1024, 1024);
        pg8::EpiResid<false, true, true> E{x_, H1B, g_mix_post, RSTD2, XSB, ctl + CW_XCNT, lds + 131072}; pg8::gemm_phase(lds, g, S, E, tid); }
    SEAM(5);
    if (IN(7)) { PHASE_IDS; pg8::Gemm g{(const char*)H1B, (const char*)WxqT, 1024, 1024, 128, 128, 1024}; pg8::StaticOrder S; S.init(MTOK, 1024, G, bx, 1024, 1024, 1024);
        pg8::EpiBf16<0> E{QX, 1024, RSTD2}; pg8::gemm_phase(lds, g, S, E, tid); }
    SEAM(7);
    if (IN(8)) { PHASE_IDS; pg8::Gemm g{(const char*)QX, (const char*)KX, 1024, 1024, 128, 128, 256}; XAttnOrder S{G, bx, false};
        pg8::EpiSoftmax E{PB, 1024, 0.0625f * att::LOG2E, lds + 131072}; pg8::gemm_phase(lds, g, S, E, tid); }
    SEAM(8);
    if (IN(10)) { PHASE_IDS; pg8::Gemm g{(const char*)PB, (const char*)VT, 1024, 8192, 128, 128, 256}; XAttnOrder S{G, bx, true};
        pg8::EpiBf16<0> E{XOIN, 1024}; pg8::gemm_phase(lds, g, S, E, tid); }
    SEAM(10);
    if (IN(11)) { PHASE_IDS; pg8::Gemm g{(const char*)XOIN, (const char*)WxoT, 1024, 1024, 128, 128, 1024}; pg8::StaticOrder S; S.init(MTOK, 1024, G, bx, 1024, 1024, 1024);
        pg8::EpiResid<true, true, true> E{H1B, GB, g_x_post, RSTD3, XSB + (size_t)2 * MTOK * 4, ctl + CW_XCNT + 2 * 256 * 64, lds + 131072}; pg8::gemm_phase(lds, g, S, E, tid); }
    SEAM(11);
    if (IN(13)) { PHASE_IDS; pg8::Gemm g{(const char*)GB, (const char*)WupT, 1024, 1024, 128, 128, 1024}; pg8::StaticOrder S; S.init(MTOK, FF, G, bx, 1024, 1024, FF);
        pg8::EpiBf16<1> E{UB, FF, RSTD3}; pg8::gemm_phase(lds, g, S, E, tid); }
    SEAM(13);
    if (IN(14)) { PHASE_IDS; pg8::Gemm g{(const char*)UB, (const char*)WdnT, FF, FF, 128, 128, FF}; pg8::StaticOrder S; S.init(MTOK, 1024, G, bx, FF, FF, 1024);
        pg8::EpiResid<true, false, false> E{GB, OUTP, g_mlp_post, nullptr, XSB + (size_t)4 * MTOK * 4, ctl + CW_XCNT + 4 * 256 * 64, lds + 131072}; pg8::gemm_phase(lds, g, S, E, tid); }
#undef IN
#undef SEAM
}

extern "C" void kernel_launch(void* const* d_in, const int* in_sizes, int n_in, void* d_out, int out_size, void* d_ws, size_t ws_size, hipStream_t stream) {
    static int grid = 0;
    if (grid == 0) {
        if (n_in != 23 || out_size != MTOK * DM || ws_size < WS_END) { fprintf(stderr, "kernel_launch: unexpected problem (n_in %d, out %d, ws %zu)\n", n_in, out_size, ws_size); grid = -1; return; }
        int dev = 0, cus = 0, per_cu = 0;
        hipGetDevice(&dev); hipDeviceGetAttribute(&cus, hipDeviceAttributeMultiprocessorCount, dev);
        if (hipFuncSetAttribute((const void*)layer_fwd, hipFuncAttributeMaxDynamicSharedMemorySize, LDS_BYTES) != hipSuccess) { fprintf(stderr, "kernel_launch: hipFuncSetAttribute failed\n"); grid = -1; return; }
        if (hipOccupancyMaxActiveBlocksPerMultiprocessor(&per_cu, (const void*)layer_fwd, NWAVES * 64, LDS_BYTES) != hipSuccess || per_cu < 1) { fprintf(stderr, "kernel_launch: occupancy query says %d\n", per_cu); per_cu = 1; }
        (void)hipGetLastError();
        grid = cus;
    }
    if (grid < 0) return;
    if (hipMemsetAsync((char*)d_ws + WS_CTL, 0, 1 << 20, stream) != hipSuccess) { fprintf(stderr, "kernel_launch: memset failed\n"); return; }
    Args a{};
    for (int i = 0; i < 23; ++i) a.in[i] = (const float*)d_in[i];
    a.out = (float*)d_out; a.ws = (unsigned char*)d_ws;
#if MK_ONE_LAUNCH
    a.ph_lo = 0; a.ph_hi = NPHASE;
    void* kargs[] = {&a};
    hipError_t e = hipLaunchCooperativeKernel((const void*)layer_fwd, dim3(grid), dim3(NWAVES * 64), kargs, LDS_BYTES, stream);
    if (e != hipSuccess) fprintf(stderr, "kernel_launch: cooperative launch failed: %s (grid %d)\n", hipGetErrorString(e), grid);
#else
    for (int p = 0; p < NPHASE; ++p) { a.ph_lo = p; a.ph_hi = p + 1; hipLaunchKernelGGL(layer_fwd, dim3(grid), dim3(NWAVES * 64), LDS_BYTES, stream, a); }
#endif
}
```

```cpp
#include <hip/hip_runtime.h>
#include <hip/hip_cooperative_groups.h>
#include <cstdio>
#include <cstdint>
namespace cg = cooperative_groups;

#ifndef MK_ONE_LAUNCH
#define MK_ONE_LAUNCH 1
#endif

#define LAS __attribute__((address_space(3)))
typedef unsigned short bf16_t;
typedef short bf16x8 __attribute__((ext_vector_type(8)));
typedef short s16x4 __attribute__((ext_vector_type(4)));
typedef float f32x2 __attribute__((ext_vector_type(2)));
typedef float f32x4 __attribute__((ext_vector_type(4)));
typedef float f32x16 __attribute__((ext_vector_type(16)));
typedef unsigned u32x2 __attribute__((ext_vector_type(2)));
typedef unsigned u32x4 __attribute__((ext_vector_type(4)));

constexpr int BATCH = 32, SEQ = 2048, DM = 1024, MTOK = BATCH * SEQ;
constexpr int NPROJ = 3072;
constexpr int MEMLEN = 256, MMEM = BATCH * MEMLEN;
constexpr int FF = 4096;
constexpr float RMS_EPS = 1e-6f;
constexpr int C_FQ = 0, C_FK = 512, C_FV = 1024, C_NQ = 1536, C_KC = 2048, C_VC = 2176, C_KS = 2304, C_VS = 2432, C_KW = 2560, C_VW = 2688, C_FF = 2816, C_NG = 2824;

constexpr size_t MiB = 1u << 20;
constexpr size_t WS_CTL = 0;
constexpr size_t WS_WIN = 2 * MiB;
constexpr size_t WS_WOUT = 8 * MiB;
constexpr size_t WS_WXQ = 10 * MiB;
constexpr size_t WS_WXKV = 12 * MiB;
constexpr size_t WS_WXO = 16 * MiB;
constexpr size_t WS_WUP = 18 * MiB;
constexpr size_t WS_WDN = 26 * MiB;
constexpr size_t WS_WC1 = 34 * MiB;
constexpr size_t WS_ROPE = 36 * MiB;
constexpr size_t WS_BIAS1 = 37 * MiB;
constexpr size_t WS_FG = 40 * MiB;
constexpr size_t WS_C2 = 48 * MiB;
constexpr size_t WS_Y = 50 * MiB;
constexpr size_t WS_KC = 82 * MiB;
constexpr size_t WS_MN = 84 * MiB;
constexpr size_t WS_KX = 100 * MiB;
constexpr size_t WS_VT = 116 * MiB;
constexpr size_t WS_N = 132 * MiB;
constexpr size_t WS_G = 260 * MiB;
constexpr size_t WS_AO = 388 * MiB;
constexpr size_t WS_PROJ = 516 * MiB;
constexpr size_t WS_QX = 516 * MiB;
constexpr size_t WS_S = 644 * MiB;
constexpr size_t WS_U = 388 * MiB;
constexpr size_t WS_END = 900 * MiB;

constexpr int CW_QUEUE = 64;
constexpr int CW_XCNT = 16384;
constexpr int CW_NORM = 8192;

__device__ __forceinline__ unsigned pk2(float lo, float hi) {
    typedef __bf16 b2 __attribute__((ext_vector_type(2)));
    f32x2 v = {lo, hi}; b2 b = __builtin_convertvector(v, b2); return __builtin_bit_cast(unsigned, b);
}
__device__ __forceinline__ float bf_lo(unsigned u) { return __uint_as_float(u << 16); }
__device__ __forceinline__ float bf_hi(unsigned u) { return __uint_as_float(u & 0xffff0000u); }
__device__ __forceinline__ float wave_sum(float v) {
#pragma unroll
    for (int o = 1; o < 64; o <<= 1) v += __shfl_xor(v, o);
    return v;
}
__device__ __forceinline__ float wave_max(float v) {
#pragma unroll
    for (int o = 1; o < 64; o <<= 1) v = fmaxf(v, __shfl_xor(v, o));
    return v;
}

namespace pg8 {
constexpr int BM = 256, BK = 64, HALF = 128, HTB = HALF * BK * 2, STAGE_BYTES = 8 * HTB, NXCD = 8, WGM = 4;

__host__ __device__ __forceinline__ int lds_byte(int r, int c) { const int st = (r >> 4) * 2 + (c >> 5), rr = r & 15, cc = c & 31, ob = rr * 64 + cc * 2; return st * 1024 + (ob ^ (((ob >> 9) & 1) << 5)); }
__host__ __device__ __forceinline__ void stage_rc(int b, int& R, int& C) { const int st = b / 1024, sb = b % 1024, swz = sb ^ (((sb >> 9) & 1) << 5); R = (st >> 1) * 16 + swz / 64; C = (st & 1) * 32 + (swz % 64) / 2; }
__host__ __device__ __forceinline__ int perm32(int rho) { const int n = rho >> 4, i = rho & 15; return 8 * (i >> 2) + 4 * n + (i & 3); }

struct Unit { int pm, pn, z; size_t aoff, boff, coff; };
struct Gemm { const char* A; const char* Bt; unsigned lda, ldb; unsigned kstepA, kstepB; int K; };

struct StaticOrder {
    int nM, nN, nwg, G, c; size_t lda, ldb, ldc;
    __device__ void init(int M, int N, int G_, int c_, size_t lda_, size_t ldb_, size_t ldc_) { nM = M / BM; nN = N / BM; nwg = nM * nN; G = G_; c = c_; lda = lda_; ldb = ldb_; ldc = ldc_; }
    __device__ bool next(int i, Unit& u) const {
        const long L = (long)i * G + c; if (L >= nwg) return false;
        int wgid = (int)L; { const int q = nwg / NXCD, r = nwg % NXCD, xcd = wgid % NXCD, off = wgid / NXCD; wgid = (xcd < r ? xcd * (q + 1) : r * (q + 1) + (xcd - r) * q) + off; }
        const int nig = WGM * nN, gid = wgid / nig, fm = gid * WGM, gsz = (nM - fm) < WGM ? (nM - fm) : WGM;
        u.pm = fm + ((wgid % nig) % gsz); u.pn = (wgid % nig) / gsz; u.z = 0;
        u.aoff = (size_t)u.pm * BM * lda * 2; u.boff = (size_t)u.pn * BM * ldb * 2; u.coff = (size_t)u.pm * BM * ldc + (size_t)u.pn * BM;
        return true;
    }
};

template <int ACT  > struct EpiBf16 {
    static constexpr bool PERM = true;
    bf16_t* O; size_t ldc; const float* rscale = nullptr;
    __device__ __forceinline__ void operator()(const f32x4 (&acc)[2][2][4][2], const Unit& u, int wr, int wc, int fr, int fq) const {
        bf16_t* base = O + u.coff + (size_t)(wr * 64 + fr) * ldc + wc * 32 + 8 * fq;
#pragma unroll
        for (int ai = 0; ai < 2; ++ai)
#pragma unroll
            for (int m = 0; m < 4; ++m) { bf16_t* rowp = base + (size_t)(ai * HALF + m * 16) * ldc;
                const float rs = rscale ? rscale[u.pm * BM + wr * 64 + fr + ai * HALF + m * 16] : 1.f;
#pragma unroll
                for (int bj = 0; bj < 2; ++bj) { f32x4 v0 = acc[ai][bj][m][0] * rs, v1 = acc[ai][bj][m][1] * rs;
                    if (ACT == 1) {
#pragma unroll
                        for (int i = 0; i < 4; ++i) { const float a = fmaxf(v0[i], 0.f), b = fmaxf(v1[i], 0.f); v0[i] = a * a; v1[i] = b * b; } }
                    u32x4 w; w.x = pk2(v0[0], v0[1]); w.y = pk2(v0[2], v0[3]); w.z = pk2(v1[0], v1[1]); w.w = pk2(v1[2], v1[3]);
                    *(u32x4*)(rowp + bj * HALF) = w; } }
    }
};
struct EpiProj {
    static constexpr bool PERM = true;
    bf16_t* O; float* FG;
    __device__ __forceinline__ void operator()(const f32x4 (&acc)[2][2][4][2], const Unit& u, int wr, int wc, int fr, int fq) const {
        if (u.pn < 11) {
            bf16_t* base = O + u.coff + (size_t)(wr * 64 + fr) * NPROJ + wc * 32 + 8 * fq;
#pragma unroll
            for (int ai = 0; ai < 2; ++ai)
#pragma unroll
                for (int m = 0; m < 4; ++m) { bf16_t* rowp = base + (size_t)(ai * HALF + m * 16) * NPROJ;
#pragma unroll
                    for (int bj = 0; bj < 2; ++bj) { const f32x4 v0 = acc[ai][bj][m][0], v1 = acc[ai][bj][m][1];
                        u32x4 w; w.x = pk2(v0[0], v0[1]); w.y = pk2(v0[2], v0[3]); w.z = pk2(v1[0], v1[1]); w.w = pk2(v1[2], v1[3]);
                        *(u32x4*)(rowp + bj * HALF) = w; } }
        } else if (wc == 0) {
            float* base = FG + (size_t)(u.pm * BM + wr * 64 + fr) * 32 + 8 * fq;
#pragma unroll
            for (int ai = 0; ai < 2; ++ai)
#pragma unroll
                for (int m = 0; m < 4; ++m) { float* rowp = base + (size_t)(ai * HALF + m * 16) * 32;
                    *(f32x4*)(rowp) = acc[ai][0][m][0]; *(f32x4*)(rowp + 4) = acc[ai][0][m][1]; }
        }
    }
};
struct EpiF32 {
    static constexpr bool PERM = false;
    float* O; size_t ldc; float scale;
    __device__ __forceinline__ void operator()(const f32x4 (&acc)[2][2][4][2], const Unit& u, int wr, int wc, int fr, int fq) const {
        float* base = O + u.coff + (size_t)(wr * 64 + fr) * ldc + wc * 32 + 4 * fq;
#pragma unroll
        for (int ai = 0; ai < 2; ++ai)
#pragma unroll
            for (int m = 0; m < 4; ++m) { float* rowp = base + (size_t)(ai * HALF + m * 16) * ldc;
#pragma unroll
                for (int bj = 0; bj < 2; ++bj)
#pragma unroll
                    for (int n = 0; n < 2; ++n) *(f32x4*)(rowp + bj * HALF + n * 16) = acc[ai][bj][m][n] * scale; }
    }
};

struct EpiSoftmax {
    static constexpr bool PERM = true;
    bf16_t* O; size_t ldc; float scale; LAS unsigned char* xl;
    __device__ __forceinline__ void operator()(f32x4 (&acc)[2][2][4][2], const Unit& u, int wr, int wc, int fr, int fq) const {
        LAS f32x2* X = (LAS f32x2*)xl;
        float mown[2][4];
#pragma unroll
        for (int ai = 0; ai < 2; ++ai)
#pragma unroll
            for (int m = 0; m < 4; ++m) {
                float mx = -INFINITY;
#pragma unroll
                for (int bj = 0; bj < 2; ++bj)
#pragma unroll
                    for (int n = 0; n < 2; ++n) { const f32x4 v = acc[ai][bj][m][n]; mx = fmaxf(mx, fmaxf(fmaxf(v[0], v[1]), fmaxf(v[2], v[3]))); }
                mx = fmaxf(mx, __shfl_xor(mx, 16)); mx = fmaxf(mx, __shfl_xor(mx, 32));
                const float ms = mx * scale; float l = 0.f;
#pragma unroll
                for (int bj = 0; bj < 2; ++bj)
#pragma unroll
                    for (int n = 0; n < 2; ++n) { f32x4 v = acc[ai][bj][m][n];
#pragma unroll
                        for (int i = 0; i < 4; ++i) { v[i] = __builtin_amdgcn_exp2f(v[i] * scale - ms); l += v[i]; }
                        acc[ai][bj][m][n] = v; }
                l += __shfl_xor(l, 16); l += __shfl_xor(l, 32);
                mown[ai][m] = ms;
                if (fq == 0) X[(ai * HALF + wr * 64 + m * 16 + fr) * 4 + wc] = (f32x2){ms, l};
            }
        asm volatile("s_waitcnt lgkmcnt(0)" ::: "memory"); __builtin_amdgcn_s_barrier(); asm volatile("" ::: "memory");
        bf16_t* base = O + u.coff + (size_t)(wr * 64 + fr) * ldc + wc * 32 + 8 * fq;
#pragma unroll
        for (int ai = 0; ai < 2; ++ai)
#pragma unroll
            for (int m = 0; m < 4; ++m) {
                const LAS f32x4* xr = (const LAS f32x4*)(X + (ai * HALF + wr * 64 + m * 16 + fr) * 4);
                const f32x4 a = xr[0], b = xr[1];
                const float M = fmaxf(fmaxf(a[0], a[2]), fmaxf(b[0], b[2]));
                const float L = (a[1] * __builtin_amdgcn_exp2f(a[0] - M) + a[3] * __builtin_amdgcn_exp2f(a[2] - M)) + (b[1] * __builtin_amdgcn_exp2f(b[0] - M) + b[3] * __builtin_amdgcn_exp2f(b[2] - M));
                const float f = __builtin_amdgcn_exp2f(mown[ai][m] - M) / L;
                bf16_t* rowp = base + (size_t)(ai * HALF + m * 16) * ldc;
#pragma unroll
                for (int bj = 0; bj < 2; ++bj) { const f32x4 v0 = acc[ai][bj][m][0] * f, v1 = acc[ai][bj][m][1] * f;
                    u32x4 w; w.x = pk2(v0[0], v0[1]); w.y = pk2(v0[2], v0[3]); w.z = pk2(v1[0], v1[1]); w.w = pk2(v1[2], v1[3]);
                    *(u32x4*)(rowp + bj * HALF) = w; }
            }
        asm volatile("s_waitcnt lgkmcnt(0)" ::: "memory"); __builtin_amdgcn_s_barrier(); asm volatile("" ::: "memory");
    }
};

template <bool HIN_BF, bool HOUT_BF, bool NEXT> struct EpiResid {
    static constexpr bool PERM = true;
    const void* hres; void* hout; const float* gpost; float* rstd_out; float* xs; unsigned* cnt; LAS unsigned char* xl;
    __device__ __forceinline__ void stats(const float (&part)[2][4], const Unit& u, int bank, int wr, int wc, int fr, int fq) const {
        LAS float* P = (LAS float*)xl;
        LAS float* S = (LAS float*)(xl + 4096);
        const int wid = wr * 4 + wc, lane = fq * 16 + fr;
#pragma unroll
        for (int ai = 0; ai < 2; ++ai)
#pragma unroll
            for (int m = 0; m < 4; ++m) { float v = part[ai][m]; v += __shfl_xor(v, 16); v += __shfl_xor(v, 32); if (fq == 0) P[(ai * HALF + wr * 64 + m * 16 + fr) * 4 + wc] = v; }
        asm volatile("s_waitcnt lgkmcnt(0)" ::: "memory"); __builtin_amdgcn_s_barrier(); asm volatile("" ::: "memory");
        const int row = wid * 32 + (lane & 31);
        unsigned* slot = (unsigned*)(xs + ((size_t)bank * MTOK + (size_t)u.pm * BM + row) * 4);
        if (lane < 32) { const f32x4 p = *(const LAS f32x4*)(P + row * 4); const float t = (p[0] + p[1]) + (p[2] + p[3]);
            __hip_atomic_store(slot + u.pn, __float_as_uint(t), __ATOMIC_RELAXED, __HIP_MEMORY_SCOPE_AGENT); }
        asm volatile("s_waitcnt vmcnt(0)" ::: "memory");
        unsigned* c = cnt + ((size_t)bank * 256 + u.pm) * 64;
        if (lane == 0) __hip_atomic_fetch_add(c, 1u, __ATOMIC_RELAXED, __HIP_MEMORY_SCOPE_AGENT);
        if (wid == 0) {
            for (unsigned sp = 0; sp < (1u << 17); ++sp) { if ((unsigned)__builtin_amdgcn_readfirstlane(__hip_atomic_load(c, __ATOMIC_RELAXED, __HIP_MEMORY_SCOPE_AGENT)) >= 32u) break; __builtin_amdgcn_s_sleep(2); }
        }
        asm volatile("s_waitcnt vmcnt(0) lgkmcnt(0)" ::: "memory"); __builtin_amdgcn_s_barrier(); asm volatile("" ::: "memory");
        if (lane < 32) { float tot = 0.f;
#pragma unroll
            for (int t = 0; t < 4; ++t) tot += __uint_as_float(__hip_atomic_load(slot + t, __ATOMIC_RELAXED, __HIP_MEMORY_SCOPE_AGENT));
            S[row] = 1.0f / sqrtf(tot * (1.f / 1024.f) + RMS_EPS); }
        asm volatile("s_waitcnt lgkmcnt(0)" ::: "memory"); __builtin_amdgcn_s_barrier(); asm volatile("" ::: "memory");
    }
    __device__ __forceinline__ void operator()(f32x4 (&acc)[2][2][4][2], const Unit& u, int wr, int wc, int fr, int fq) const {
        const LAS float* S = (const LAS float*)(xl + 4096);
        float part[2][4];
#pragma unroll
        for (int ai = 0; ai < 2; ++ai)
#pragma unroll
            for (int m = 0; m < 4; ++m) { float sq = 0.f;
#pragma unroll
                for (int bj = 0; bj < 2; ++bj)
#pragma unroll
                    for (int n = 0; n < 2; ++n) { const f32x4 v = acc[ai][bj][m][n]; sq += (v[0] * v[0] + v[1] * v[1]) + (v[2] * v[2] + v[3] * v[3]); }
                part[ai][m] = sq; }
        const int col0 = u.pn * BM + wc * 32 + 8 * fq;
        constexpr int NPRE = HIN_BF ? 4 : 2;
        f32x4 pre[NPRE][2][2];
#pragma unroll
        for (int m = 0; m < NPRE; ++m) { const size_t off = (size_t)(u.pm * BM + wr * 64 + m * 16 + fr) * 1024 + col0;
#pragma unroll
            for (int bj = 0; bj < 2; ++bj) {
                if (HIN_BF) { const u32x4 w = *(const u32x4*)((const bf16_t*)hres + off + bj * HALF); pre[m][bj][0] = __builtin_bit_cast(f32x4, w); }
                else { pre[m][bj][0] = *(const f32x4*)((const float*)hres + off + bj * HALF); pre[m][bj][1] = *(const f32x4*)((const float*)hres + off + bj * HALF + 4); } } }
        stats(part, u, 0, wr, wc, fr, fq);
        f32x4 g[2][2];
#pragma unroll
        for (int bj = 0; bj < 2; ++bj) { g[bj][0] = *(const f32x4*)(gpost + col0 + bj * HALF); g[bj][1] = *(const f32x4*)(gpost + col0 + bj * HALF + 4); }
#pragma unroll
        for (int ai = 0; ai < 2; ++ai)
#pragma unroll
            for (int m = 0; m < 4; ++m) { const int rl = ai * HALF + wr * 64 + m * 16 + fr; const float rs = S[rl]; const size_t off = (size_t)(u.pm * BM + rl) * 1024 + col0; float sq = 0.f;
#pragma unroll
                for (int bj = 0; bj < 2; ++bj) { f32x4 h0, h1;
                    if (HIN_BF) { u32x4 w; if (ai == 0 && m < NPRE) w = __builtin_bit_cast(u32x4, pre[m < NPRE ? m : 0][bj][0]); else w = *(const u32x4*)((const bf16_t*)hres + off + bj * HALF);
                        h0 = (f32x4){bf_lo(w.x), bf_hi(w.x), bf_lo(w.y), bf_hi(w.y)}; h1 = (f32x4){bf_lo(w.z), bf_hi(w.z), bf_lo(w.w), bf_hi(w.w)}; }
                    else { if (ai == 0 && m < NPRE) { h0 = pre[m < NPRE ? m : 0][bj][0]; h1 = pre[m < NPRE ? m : 0][bj][1]; } else { h0 = *(const f32x4*)((const float*)hres + off + bj * HALF); h1 = *(const f32x4*)((const float*)hres + off + bj * HALF + 4); } }
                    h0 += acc[ai][bj][m][0] * rs * g[bj][0]; h1 += acc[ai][bj][m][1] * rs * g[bj][1];
                    if (HOUT_BF) { u32x4 w; w.x = pk2(h0[0], h0[1]); w.y = pk2(h0[2], h0[3]); w.z = pk2(h1[0], h1[1]); w.w = pk2(h1[2], h1[3]); *(u32x4*)((bf16_t*)hout + off + bj * HALF) = w; }
                    else { *(f32x4*)((float*)hout + off + bj * HALF) = h0; *(f32x4*)((float*)hout + off + bj * HALF + 4) = h1; }
                    if (NEXT) sq += ((h0[0] * h0[0] + h0[1] * h0[1]) + (h0[2] * h0[2] + h0[3] * h0[3])) + ((h1[0] * h1[0] + h1[1] * h1[1]) + (h1[2] * h1[2] + h1[3] * h1[3])); }
                part[ai][m] = sq; }
        if (NEXT) {
            stats(part, u, 1, wr, wc, fr, fq);
            if (u.pn == 0 && wc == 0 && fq == 0) {
#pragma unroll
                for (int ai = 0; ai < 2; ++ai)
#pragma unroll
                    for (int m = 0; m < 4; ++m) { const int rl = ai * HALF + wr * 64 + m * 16 + fr; rstd_out[u.pm * BM + rl] = S[rl]; }
            }
            asm volatile("s_waitcnt lgkmcnt(0)" ::: "memory"); __builtin_amdgcn_s_barrier(); asm volatile("" ::: "memory");
        }
    }
};

template <class Epi, class Sched>
__device__ __forceinline__ void gemm_phase(LAS unsigned char* lds, const Gemm g, const Sched& S, const Epi& E, const int tid) {
    const int wid = __builtin_amdgcn_readfirstlane(tid >> 6), lane = tid & 63, wr = wid >> 2, wc = wid & 3, fr = lane & 15, fq = lane >> 4;
    const int K = g.K, nt = K / BK;
    unsigned voffA[2], voffB[2];
#pragma unroll
    for (int i = 0; i < 2; ++i) { int R, C; stage_rc(tid * 16 + i * 8192, R, C); const int Rb = Epi::PERM ? ((R & ~31) + perm32(R & 31)) : R;
        voffA[i] = (unsigned)(R * g.lda + C) * 2u; voffB[i] = (unsigned)(Rb * g.ldb + C) * 2u; }
    const size_t kstepA = g.kstepA, kstepB = g.kstepB;
    const size_t hstepA = (size_t)HALF * g.lda * 2, hstepB = (size_t)HALF * g.ldb * 2;
    const unsigned ldsw = (unsigned)wid * 1024u;
    const int aoff = lds_byte(wr * 64 + fr, fq * 8), boff = lds_byte(wc * 32 + fr, fq * 8);
#define PG8_SA(b, h) (((b) * 2 + (h)) * HTB)
#define PG8_SB(b, h) ((4 + (b) * 2 + (h)) * HTB)
#define PG8_STAGE(bufoff, gbase, voff) do { _Pragma("unroll") for (int _i = 0; _i < 2; ++_i) \
        __builtin_amdgcn_global_load_lds((const unsigned*)((const char*)(gbase) + (voff)[_i]), (LAS unsigned*)(lds + (bufoff) + ldsw + _i * 8192), 16, 0, 0); } while (0)
#define PG8_LDA(dst, b, h) do { _Pragma("unroll") for (int m = 0; m < 4; ++m) _Pragma("unroll") for (int k = 0; k < 2; ++k) dst[m][k] = *(const LAS bf16x8*)(lds + PG8_SA(b, h) + aoff + m * 2048 + k * 1024); } while (0)
#define PG8_LDB(dst, b, h) do { _Pragma("unroll") for (int n = 0; n < 2; ++n) _Pragma("unroll") for (int k = 0; k < 2; ++k) dst[n][k] = *(const LAS bf16x8*)(lds + PG8_SB(b, h) + boff + n * 2048 + k * 1024); } while (0)
#define PG8_MMA(ai, bj, At, Bt) do { __builtin_amdgcn_s_setprio(1); _Pragma("unroll") for (int m = 0; m < 4; ++m) _Pragma("unroll") for (int n = 0; n < 2; ++n) _Pragma("unroll") for (int k = 0; k < 2; ++k) \
        acc[ai][bj][m][n] = __builtin_amdgcn_mfma_f32_16x16x32_bf16(Bt[n][k], At[m][k], acc[ai][bj][m][n], 0, 0, 0); __builtin_amdgcn_s_setprio(0); } while (0)
#define PG8_WAIT_V(n) asm volatile("s_waitcnt vmcnt(" #n ")" ::: "memory")
#define PG8_WAIT_L(n) asm volatile("s_waitcnt lgkmcnt(" #n ")" ::: "memory")
#define PG8_BAR __builtin_amdgcn_s_barrier()
#define PG8_SCHED __builtin_amdgcn_sched_barrier(0)
    Unit cur, nxt; int ui = 0;
    if (!S.next(0, cur)) return;
    f32x4 acc[2][2][4][2];
#pragma unroll
    for (int a = 0; a < 2; ++a)
#pragma unroll
        for (int b = 0; b < 2; ++b)
#pragma unroll
            for (int m = 0; m < 4; ++m)
#pragma unroll
                for (int n = 0; n < 2; ++n) acc[a][b][m][n] = (f32x4){0.f, 0.f, 0.f, 0.f};
    bf16x8 At[4][2], B0[2][2], B1[2][2];
    const char* cA = g.A + cur.aoff; const char* cB = g.Bt + cur.boff;
    PG8_STAGE(PG8_SB(0, 0), cB, voffB); PG8_STAGE(PG8_SB(0, 1), cB + hstepB, voffB); PG8_STAGE(PG8_SA(0, 0), cA, voffA); PG8_STAGE(PG8_SA(0, 1), cA + hstepA, voffA);
    if (wr == 1) PG8_BAR;
    PG8_WAIT_V(2); PG8_BAR;
    PG8_STAGE(PG8_SB(1, 0), cB + kstepB, voffB); PG8_STAGE(PG8_SA(1, 0), cA + kstepA, voffA); PG8_STAGE(PG8_SB(1, 1), cB + hstepB + kstepB, voffB);
    PG8_WAIT_V(6); PG8_BAR;
    for (;;) {
        const bool has_next = S.next(ui + 1, nxt);
        const char* nA = has_next ? g.A + nxt.aoff : cA; const char* nB = has_next ? g.Bt + nxt.boff : cB;
        for (int t = 0; t < nt; t += 2) {
            const bool last = (t == nt - 2);
            const char* a1 = cA + (size_t)(t + 1) * kstepA;
            const char* a2 = last ? nA : cA + (size_t)(t + 2) * kstepA; const char* b2 = last ? nB : cB + (size_t)(t + 2) * kstepB;
            const char* a3 = a2 + kstepA; const char* b3 = b2 + kstepB;
            PG8_LDB(B0, 0, 0); PG8_LDB(B1, 0, 1); PG8_SCHED; PG8_LDA(At, 0, 0); PG8_STAGE(PG8_SA(1, 1), a1 + hstepA, voffA);
            PG8_WAIT_V(8); PG8_WAIT_L(0); PG8_BAR; PG8_MMA(0, 0, At, B0); PG8_MMA(0, 1, At, B1); PG8_BAR; PG8_SCHED;
            PG8_LDA(At, 0, 1); PG8_STAGE(PG8_SB(0, 0), b2, voffB); PG8_STAGE(PG8_SB(0, 1), b2 + hstepB, voffB); PG8_STAGE(PG8_SA(0, 0), a2, voffA);
            PG8_WAIT_V(8); PG8_WAIT_L(0); PG8_BAR; PG8_MMA(1, 0, At, B0); PG8_MMA(1, 1, At, B1); PG8_BAR; PG8_SCHED;
            PG8_LDB(B0, 1, 0); PG8_LDB(B1, 1, 1); PG8_SCHED; PG8_LDA(At, 1, 0); PG8_STAGE(PG8_SA(0, 1), a2 + hstepA, voffA);
            PG8_WAIT_V(8); PG8_WAIT_L(0); PG8_BAR; PG8_MMA(0, 0, At, B0); PG8_MMA(0, 1, At, B1); PG8_BAR; PG8_SCHED;
            PG8_LDA(At, 1, 1); PG8_STAGE(PG8_SB(1, 0), b3, voffB); PG8_STAGE(PG8_SB(1, 1), b3 + hstepB, voffB); PG8_STAGE(PG8_SA(1, 0), a3, voffA);
            PG8_WAIT_V(8); PG8_WAIT_L(0); PG8_BAR; PG8_MMA(1, 0, At, B0); PG8_MMA(1, 1, At, B1); PG8_BAR; PG8_SCHED;
        }
        if (wr == 0) PG8_BAR;
        E(acc, cur, wr, wc, fr, fq);
        if (!has_next) break;
#pragma unroll
        for (int a = 0; a < 2; ++a)
#pragma unroll
            for (int b = 0; b < 2; ++b)
#pragma unroll
                for (int m = 0; m < 4; ++m)
#pragma unroll
                    for (int n = 0; n < 2; ++n) acc[a][b][m][n] = (f32x4){0.f, 0.f, 0.f, 0.f};
        cur = nxt; cA = nA; cB = nB; ++ui;
        if (wr == 1) PG8_BAR;
    }
    PG8_WAIT_V(0);
    PG8_BAR;
#undef PG8_SA
#undef PG8_SB
#undef PG8_STAGE
#undef PG8_LDA
#undef PG8_LDB
#undef PG8_MMA
#undef PG8_WAIT_V
#undef PG8_WAIT_L
#undef PG8_BAR
#undef PG8_SCHED
}
}

namespace att {
constexpr float LOG2E = 1.4426950408889634f;
constexpr float C2 = 0.125f * LOG2E;
constexpr float THR = 8.f;
constexpr int L_KV = 0;
constexpr int L_IMP = 32768;
constexpr int L_CK = 65536;
constexpr int L_WS = 66560;
constexpr int L_OST = 68608;
constexpr int L_ISUM = 134144;
constexpr int L_MASK = 142336;
constexpr int L_MISC = 142592;

struct KVSrc { const bf16_t* k; const bf16_t* v; int pitch; int nrows; };

__device__ __forceinline__ void glds16(const void* gsrc, unsigned lds_dst) { unsigned keep;
    asm volatile("s_mov_b32 %0, m0\n\ts_mov_b32 m0, %2\n\ts_nop 0\n\tglobal_load_lds_dwordx4 %1, off\n\ts_mov_b32 m0, %0" : "=&s"(keep) : "v"(gsrc), "s"(lds_dst) : "memory"); }
__device__ __forceinline__ void glds4(const void* gsrc, unsigned lds_dst) { unsigned keep;
    asm volatile("s_mov_b32 %0, m0\n\ts_mov_b32 m0, %2\n\ts_nop 0\n\tglobal_load_lds_dword %1, off\n\ts_mov_b32 m0, %0" : "=&s"(keep) : "v"(gsrc), "s"(lds_dst) : "memory"); }
#define WAIT_BAR(N) asm volatile("s_waitcnt vmcnt(" #N ") lgkmcnt(0)\n\ts_barrier" ::: "memory")
__device__ __forceinline__ void dma_tile(LAS unsigned char* lds, int stage, const KVSrc& s, int key0, int wid, int lane) {
    const unsigned base = (unsigned)(unsigned long long)(lds + L_KV) + (unsigned)(stage * 16384 + wid * 1024);
    int kr = key0 + lane; kr = kr < 0 ? 0 : (kr >= s.nrows ? s.nrows - 1 : kr);
    const bf16_t* ks = s.k + (size_t)kr * s.pitch + wid * 8;
    glds16(ks, (unsigned)__builtin_amdgcn_readfirstlane(base));
    int vr = key0 + 16 * (wid & 3) + (lane >> 2); vr = vr < 0 ? 0 : (vr >= s.nrows ? s.nrows - 1 : vr);
    const bf16_t* vs = s.v + (size_t)vr * s.pitch + (wid >> 2) * 32 + (lane & 3) * 8;
    glds16(vs, (unsigned)__builtin_amdgcn_readfirstlane(base + 8192u));
}

__device__ __forceinline__ void qkt(f32x16& p0, f32x16& p1, const LAS unsigned char* Kslot, const bf16x8 (&qr)[4], const f32x16& c0, const f32x16& c1, int r32, int hi) {
    const LAS unsigned char* kb = Kslot + hi * 1024 + r32 * 16;
    f32x16 a, b;
    { const bf16x8 b0 = *(const LAS bf16x8*)(kb), b1 = *(const LAS bf16x8*)(kb + 512);
      a = __builtin_amdgcn_mfma_f32_32x32x16_bf16(b0, qr[0], c0, 0, 0, 0); b = __builtin_amdgcn_mfma_f32_32x32x16_bf16(b1, qr[0], c1, 0, 0, 0); }
#pragma unroll
    for (int d0 = 1; d0 < 4; ++d0) {
        const bf16x8 b0 = *(const LAS bf16x8*)(kb + d0 * 2048);
        const bf16x8 b1 = *(const LAS bf16x8*)(kb + d0 * 2048 + 512);
        a = __builtin_amdgcn_mfma_f32_32x32x16_bf16(b0, qr[d0], a, 0, 0, 0);
        b = __builtin_amdgcn_mfma_f32_32x32x16_bf16(b1, qr[d0], b, 0, 0, 0);
    }
    p0 = a; p1 = b;
}
typedef short v4i16_t __attribute__((ext_vector_type(4)));
__device__ __forceinline__ s16x4 vtr(const LAS unsigned char* p) { return __builtin_bit_cast(s16x4, __builtin_amdgcn_ds_read_tr16_b64_v4i16((LAS v4i16_t*)p)); }
__device__ __forceinline__ void pv(f32x16 (&o)[2], f32x16& lacc, const LAS unsigned char* Vslot, const bf16x8 (&pa)[4], int lane, int hi) {
    const LAS unsigned char* vp = Vslot + ((lane >> 4) & 1) * 32 + (lane & 3) * 8 + (4 * hi + ((lane & 15) >> 2)) * 64;
    const bf16x8 ones = {16256, 16256, 16256, 16256, 16256, 16256, 16256, 16256};
#pragma unroll
    for (int ks = 0; ks < 4; ++ks) {
#pragma unroll
        for (int d0 = 0; d0 < 2; ++d0) {
            const s16x4 lo = vtr(vp + d0 * 4096 + ks * 1024), hh = vtr(vp + d0 * 4096 + ks * 1024 + 512);
            const bf16x8 vf = {lo[0], lo[1], lo[2], lo[3], hh[0], hh[1], hh[2], hh[3]};
            o[d0] = __builtin_amdgcn_mfma_f32_32x32x16_bf16(pa[ks], vf, o[d0], 0, 0, 0);
        }
        lacc = __builtin_amdgcn_mfma_f32_32x32x16_bf16(pa[ks], ones, lacc, 0, 0, 0);
    }
}
__device__ __forceinline__ bf16x8 pack8(const f32x16& p, int b) {
    u32x4 w; w.x = pk2(p[b], p[b + 1]); w.y = pk2(p[b + 2], p[b + 3]); w.z = pk2(p[b + 4], p[b + 5]); w.w = pk2(p[b + 6], p[b + 7]);
    return __builtin_bit_cast(bf16x8, w);
}
__device__ __forceinline__ float max3f(float a, float b, float c) { float r; asm("v_max3_f32 %0, %1, %2, %3" : "=v"(r) : "v"(a), "v"(b), "v"(c)); return r; }
__device__ __forceinline__ float max2f(float a, float b) { float r; asm("v_max_f32_e32 %0, %1, %2" : "=v"(r) : "v"(a), "v"(b)); return r; }
__device__ __forceinline__ float rowmax(const f32x16& p0, const f32x16& p1) {
    float a = max3f(p0[0], p0[1], p1[0]), b = max3f(p0[2], p0[3], p1[1]); a = max3f(a, p1[2], p1[3]);
#pragma unroll
    for (int r = 4; r < 16; r += 4) { a = max3f(a, p0[r], p0[r + 1]); b = max3f(b, p0[r + 2], p0[r + 3]); a = max3f(a, p1[r], p1[r + 1]); b = max3f(b, p1[r + 2], p1[r + 3]); }
    const float m = max2f(a, b);
    return max2f(m, __shfl_xor(m, 32));
}
__device__ __forceinline__ void load_rowfac(f32x4 (&a)[4], LAS float* ws, float f, int r32, int hi) {
    asm volatile("" ::: "memory");
    if (hi == 0) ws[r32] = f;
    asm volatile("s_waitcnt lgkmcnt(0)" ::: "memory");
#pragma unroll
    for (int k4 = 0; k4 < 4; ++k4) a[k4] = *(const LAS f32x4*)(ws + 8 * k4 + 4 * hi);
    asm volatile("s_waitcnt lgkmcnt(0)" ::: "memory");
}

template <int MODE>
__device__ __forceinline__ void flash_sweep(LAS unsigned char* lds, const KVSrc& src, const bf16x8 (&qr)[4], f32x16 (&o)[2], f32x16& lacc,
                                            unsigned tiles, int qpos, int wq_min, int wq_max, unsigned rowmask, const float* ck2, float cq2,
                                            int wid, int lane, const bool first_issued = false) {
    const int r32 = lane & 31, hi = lane >> 5;
    LAS float* ws = (LAS float*)(lds + L_WS + wid * 256);
    f32x16 negm;
#pragma unroll
    for (int r = 0; r < 16; ++r) { o[0][r] = 0.f; o[1][r] = 0.f; lacc[r] = 0.f; negm[r] = 0.f; }
    float mhat = 0.f; bool fresh = true;
    unsigned ri = tiles, rc = tiles; int issued = 0, it = 0;
    const unsigned ckbase = (unsigned)(unsigned long long)(lds + L_CK);
    if (first_issued) { ri &= ri - 1; issued = 1; }
#pragma unroll 1
    for (int k = issued; k < 3 && ri; ++k) { const int jn = __builtin_ctz(ri); ri &= ri - 1; dma_tile(lds, issued & 3, src, 64 * jn, wid, lane);
        if (MODE == 0 && wid == 0) glds4(ck2 + 64 * jn + lane, (unsigned)__builtin_amdgcn_readfirstlane(ckbase + (issued & 3) * 256)); ++issued; }
#pragma unroll 1
    while (rc) {
        const int j = __builtin_ctz(rc); rc &= rc - 1;
        const int ahead = issued - it - 1, st = it & 3;
        if (MODE == 0 && wid == 0) { if (ahead >= 2) WAIT_BAR(6); else if (ahead == 1) WAIT_BAR(3); else WAIT_BAR(0); }
        else { if (ahead >= 2) WAIT_BAR(4); else if (ahead == 1) WAIT_BAR(2); else WAIT_BAR(0); }
        if (ri) { const int jn = __builtin_ctz(ri); ri &= ri - 1; dma_tile(lds, issued & 3, src, 64 * jn, wid, lane);
            if (MODE == 0 && wid == 0) glds4(ck2 + 64 * jn + lane, (unsigned)__builtin_amdgcn_readfirstlane(ckbase + (issued & 3) * 256)); ++issued; }
        ++it;
        const int k0 = 64 * j;
        const bool skip = (k0 > wq_max) || (MODE == 2 && k0 + 63 <= wq_min - 512);
        if (!skip) {
            const LAS unsigned char* Ks = lds + L_KV + st * 16384;
            f32x16 p0, p1;
            if (MODE == 0) {
                const LAS float* ckp = (const LAS float*)(lds + L_CK + st * 256);
                const float base = cq2 - mhat; f32x16 c0v, c1v;
#pragma unroll
                for (int k4 = 0; k4 < 4; ++k4) { const f32x4 c0 = *(const LAS f32x4*)(ckp + 8 * k4 + 4 * hi), c1 = *(const LAS f32x4*)(ckp + 32 + 8 * k4 + 4 * hi);
#pragma unroll
                    for (int i = 0; i < 4; ++i) { c0v[4 * k4 + i] = base - c0[i]; c1v[4 * k4 + i] = base - c1[i]; } }
                qkt(p0, p1, Ks, qr, c0v, c1v, r32, hi);
            } else qkt(p0, p1, Ks, qr, negm, negm, r32, hi);
            const int qrel = qpos - k0 - 4 * hi;
            if (k0 + 63 > wq_min) {
                asm volatile("" ::: "memory");
#pragma unroll
                for (int r = 0; r < 16; ++r) { const int c = (r & 3) + 8 * (r >> 2); if (c > qrel) p0[r] = -INFINITY; if (c + 32 > qrel) p1[r] = -INFINITY; }
            }
            if (MODE == 2 && k0 <= wq_max - 512) {
                asm volatile("" ::: "memory");
#pragma unroll
                for (int r = 0; r < 16; ++r) { const int c = (r & 3) + 8 * (r >> 2); if (c <= qrel - 512) p0[r] = -INFINITY; if (c + 32 <= qrel - 512) p1[r] = -INFINITY; }
            }
            if (MODE == 1) {
                if (!__all((rowmask >> j) & 1u)) {
                    asm volatile("" ::: "memory");
                    const bool dead = !((rowmask >> j) & 1u);
#pragma unroll
                    for (int r = 0; r < 16; ++r) { if (dead) { p0[r] = -INFINITY; p1[r] = -INFINITY; } }
                }
            }
            const float rm = rowmax(p0, p1);
            const bool need = fresh ? (rm > -INFINITY) : (rm > THR);
            if (__any(need)) {
                asm volatile("" ::: "memory");
                const float dl = need ? (fresh ? rm : fmaxf(rm, 0.f)) : 0.f;
                const float alpha = fresh ? 1.f : __builtin_amdgcn_exp2f(-dl);
                mhat += dl; fresh = fresh && !need;
#pragma unroll
                for (int r = 0; r < 16; ++r) { p0[r] -= dl; p1[r] -= dl; negm[r] = -mhat; }
                f32x4 a[4]; load_rowfac(a, ws, alpha, r32, hi);
#pragma unroll
                for (int k4 = 0; k4 < 4; ++k4)
#pragma unroll
                    for (int i = 0; i < 4; ++i) { o[0][4 * k4 + i] *= a[k4][i]; o[1][4 * k4 + i] *= a[k4][i]; lacc[4 * k4 + i] *= a[k4][i]; }
            }
#pragma unroll
            for (int r = 0; r < 16; ++r) { p0[r] = __builtin_amdgcn_exp2f(p0[r]); p1[r] = __builtin_amdgcn_exp2f(p1[r]); }
            bf16x8 pa[4]; pa[0] = pack8(p0, 0); pa[1] = pack8(p0, 8); pa[2] = pack8(p1, 0); pa[3] = pack8(p1, 8);
            pv(o, lacc, Ks + 8192, pa, lane, hi);
        }
    }
    WAIT_BAR(0);
}

__device__ __forceinline__ void store_o(LAS unsigned char* lds, const f32x16 (&o)[2], const f32x16& fac, bf16_t* Ow, size_t pitch, int wid, int lane) {
    const int r32 = lane & 31, hi = lane >> 5;
    LAS bf16_t* stg = (LAS bf16_t*)(lds + L_OST + wid * 4096);
#pragma unroll
    for (int r = 0; r < 16; ++r) { const int orow = (r & 3) + 8 * (r >> 2) + 4 * hi;
#pragma unroll
        for (int d0 = 0; d0 < 2; ++d0) { const unsigned w = pk2(o[d0][r] * fac[r], 0.f); stg[orow * 64 + d0 * 32 + r32] = (bf16_t)(w & 0xffffu); } }
    asm volatile("s_waitcnt lgkmcnt(0)" ::: "memory");
#pragma unroll
    for (int i = 0; i < 4; ++i) { const int row = i * 8 + (lane >> 3), ch = lane & 7; const u32x4 v = *(const LAS u32x4*)(stg + row * 64 + ch * 8); *(u32x4*)(Ow + (size_t)row * pitch + ch * 8) = v; }
    asm volatile("s_waitcnt lgkmcnt(0)" ::: "memory");
}


template <bool FIRST>
__device__ __forceinline__ void acc_tile(LAS float* tl, const f32x16 (&o)[2], const f32x16& fac, int r32, int hi) {
#pragma unroll
    for (int r = 0; r < 16; ++r) { const int orow = (r & 3) + 8 * (r >> 2) + 4 * hi; const float f = fac[r];
#pragma unroll
        for (int d0 = 0; d0 < 2; ++d0) { LAS float* p = tl + orow * 64 + d0 * 32 + r32; if (FIRST) *p = o[d0][r] * f; else *p += o[d0][r] * f; } }
}
__device__ __forceinline__ void store_tile(const LAS float* tl, bf16_t* Ow, size_t pitch, int lane) {
    asm volatile("s_waitcnt lgkmcnt(0)" ::: "memory");
#pragma unroll
    for (int i = 0; i < 4; ++i) { const int row = i * 8 + (lane >> 3), ch = lane & 7; const f32x4 v0 = *(const LAS f32x4*)(tl + row * 64 + ch * 8), v1 = *(const LAS f32x4*)(tl + row * 64 + ch * 8 + 4);
        u32x4 w; w.x = pk2(v0[0], v0[1]); w.y = pk2(v0[2], v0[3]); w.z = pk2(v1[0], v1[1]); w.w = pk2(v1[2], v1[3]); *(u32x4*)(Ow + (size_t)row * pitch + ch * 8) = w; }
    asm volatile("s_waitcnt lgkmcnt(0)" ::: "memory");
}

__device__ __forceinline__ bf16x8 scale_q(bf16x8 q) {
    const u32x4 w = __builtin_bit_cast(u32x4, q); u32x4 o;
#pragma unroll
    for (int i = 0; i < 4; ++i) o[i] = pk2(bf_lo(w[i]) * C2, bf_hi(w[i]) * C2);
    return __builtin_bit_cast(bf16x8, o);
}
__device__ __forceinline__ void fox_unit(LAS unsigned char* lds, int b, int h, int qb, const bf16_t* PROJ, const float* C2buf, const float* nrm, bf16_t* AO, int wid, int lane) {
    const int r32 = lane & 31, hi = lane >> 5;
    const size_t rowbase = (size_t)b * SEQ;
    const int q0 = qb * 256 + wid * 32, qpos = q0 + r32;
    const bf16_t* Qp = PROJ + (rowbase + qpos) * NPROJ + C_FQ + h * 64;
    bf16x8 qr[4];
#pragma unroll
    for (int d0 = 0; d0 < 4; ++d0) qr[d0] = scale_q(*(const bf16x8*)(Qp + d0 * 16 + hi * 8));
    const float* ck2 = C2buf + ((size_t)b * 8 + h) * SEQ;
    float cq2 = ck2[qpos];
    asm volatile("" : "+v"(qr[0]), "+v"(qr[1]), "+v"(qr[2]), "+v"(qr[3]), "+v"(cq2));
    KVSrc src{PROJ + rowbase * NPROJ + C_FK + h * 64, PROJ + rowbase * NPROJ + C_FV + h * 64, NPROJ, SEQ};
    const int nt = 4 * qb + 4;
    unsigned tiles = nt >= 32 ? 0xffffffffu : ((1u << nt) - 1u);
    {
        const float smax = C2 * sqrtf(nrm[0]) * sqrtf(nrm[1]) * 1.01f + 0.01f;
        const int kt = lane < 32 ? lane : 31; const float dec = ck2[64 * kt + 63] - ck2[qb * 256];
        const unsigned keep = (unsigned)__ballot(dec <= 2.f * smax + 40.f);
        tiles &= keep | (0xfu << (4 * qb));
    }
    f32x16 o[2], lacc;
    flash_sweep<0>(lds, src, qr, o, lacc, tiles, qpos, q0, q0 + 31, 0u, ck2, cq2, wid, lane);
#pragma unroll
    for (int r = 0; r < 16; ++r) lacc[r] = __builtin_amdgcn_rcpf(lacc[r]);
    store_o(lds, o, lacc, AO + (rowbase + q0) * DM + h * 64, DM, wid, lane);
}

__device__ __forceinline__ void nsa_unit(LAS unsigned char* lds, int b, int g, int pb, const bf16_t* PROJ, const bf16_t* KC, const float* FG, const f32x2* ROPE, bf16_t* AO, int wid, int lane) {
    const int tid = wid * 64 + lane, r32 = lane & 31, hi = lane >> 5;
    const int hr = wid & 3, ph = wid >> 2, hd = 4 * g + hr;
    const size_t rowbase = (size_t)b * SEQ;
    const int q0 = pb * 64 + ph * 32, qpos = q0 + r32;
    LAS float* ws = (LAS float*)(lds + L_WS + wid * 256);
    const bf16_t* Qp = PROJ + (rowbase + qpos) * NPROJ + C_NQ + hd * 64;
    bf16x8 qr[4];
#pragma unroll
    for (int d0 = 0; d0 < 4; ++d0) qr[d0] = scale_q(*(const bf16x8*)(Qp + d0 * 16 + hi * 8));
    const float* gp = FG + (rowbase + qpos) * 32 + 8 + hd * 3;
    float g0 = 1.f / (1.f + __expf(-gp[0])), g1 = 1.f / (1.f + __expf(-gp[1])), g2 = 1.f / (1.f + __expf(-gp[2]));
    LAS float* tl = (LAS float*)(lds + L_OST + wid * 8192);
    {
        const bf16_t* kc = KC + ((size_t)(b * 2 + g) * 2 + 0) * 128 * 64; const bf16_t* vc = kc + 128 * 64;
        KVSrc csrc{kc, vc, 64, 128};
        dma_tile(lds, 0, csrc, 0, wid, lane); dma_tile(lds, 1, csrc, 64, wid, lane);
        WAIT_BAR(0);
        asm volatile("" : "+v"(qr[0]), "+v"(qr[1]), "+v"(qr[2]), "+v"(qr[3]), "+v"(g0), "+v"(g1), "+v"(g2));
        f32x16 zero16, lc, sc[4];
#pragma unroll
        for (int r = 0; r < 16; ++r) { zero16[r] = 0.f; lc[r] = 0.f; }
        const int nthr = ((qpos - 31) >> 4) - 4 * hi;
        qkt(sc[0], sc[1], lds + L_KV, qr, zero16, zero16, r32, hi);
        qkt(sc[2], sc[3], lds + L_KV + 16384, qr, zero16, zero16, r32, hi);
        float m = -INFINITY;
#pragma unroll
        for (int tp = 0; tp < 4; ++tp)
#pragma unroll
            for (int r = 0; r < 16; ++r) { const int n = 32 * tp + (r & 3) + 8 * (r >> 2); float v = sc[tp][r]; if (n > nthr) v = -INFINITY; sc[tp][r] = v; m = fmaxf(m, v); }
        m = fmaxf(m, __shfl_xor(m, 32));
        const float ms = (m == -INFINITY) ? 0.f : m;
        float l = 0.f;
#pragma unroll
        for (int tp = 0; tp < 4; ++tp)
#pragma unroll
            for (int r = 0; r < 16; ++r) { sc[tp][r] = __builtin_amdgcn_exp2f(sc[tp][r] - ms); l += sc[tp][r]; }
        l += __shfl_xor(l, 32);
        const float inv = l > 0.f ? 1.f / l : 0.f;
        f32x16 o[2];
#pragma unroll
        for (int r = 0; r < 16; ++r) { o[0][r] = 0.f; o[1][r] = 0.f; }
        LAS float* impw = (LAS float*)(lds + L_IMP) + ((size_t)hr * 64 + ph * 32 + r32) * 33;
        float carry = 0.f;
#pragma unroll
        for (int tp = 0; tp < 4; ++tp) {
#pragma unroll
            for (int r = 0; r < 16; ++r) sc[tp][r] *= inv;
#pragma unroll
            for (int k = 0; k < 4; ++k) { const float G = (sc[tp][4 * k] + sc[tp][4 * k + 1]) + (sc[tp][4 * k + 2] + sc[tp][4 * k + 3]); const float pe = __shfl_xor(sc[tp][4 * k + 3], 32);
                impw[8 * tp + 2 * k + hi] = G + (hi ? pe : carry); carry = pe; }
        }
#pragma unroll
        for (int ti = 0; ti < 2; ++ti) {
            bf16x8 pa[4]; pa[0] = pack8(sc[2 * ti], 0); pa[1] = pack8(sc[2 * ti], 8); pa[2] = pack8(sc[2 * ti + 1], 0); pa[3] = pack8(sc[2 * ti + 1], 8);
            pv(o, lc, lds + L_KV + ti * 16384 + 8192, pa, lane, hi);
        }
        f32x4 a[4]; load_rowfac(a, ws, g0, r32, hi); f32x16 fac;
#pragma unroll
        for (int r = 0; r < 16; ++r) fac[r] = a[r >> 2][r & 3];
        acc_tile<true>(tl, o, fac, r32, hi);
    }
    asm volatile("s_waitcnt lgkmcnt(0)\n\ts_barrier" ::: "memory");
    {
        KVSrc s0{PROJ + rowbase * NPROJ + C_KS + g * 64, PROJ + rowbase * NPROJ + C_VS + g * 64, NPROJ, SEQ};
        dma_tile(lds, 0, s0, 0, wid, lane);
    }
    {
        const int pos = tid >> 3, jq = tid & 7;
        const LAS float* ip = (const LAS float*)(lds + L_IMP) + (size_t)pos * 33 + 4 * jq;
        f32x4 v;
#pragma unroll
        for (int i = 0; i < 4; ++i) v[i] = ((ip[i] + ip[64 * 33 + i]) + ip[2 * 64 * 33 + i]) + ip[3 * 64 * 33 + i];
#pragma unroll
        for (int i = 0; i < 4; ++i) { const int jj = 4 * jq + i; float x = v[i];
            if (jj == pb) x = 2.0e4f; else if (jj == 0 || jj == pb - 1) x = 1.0e4f;
            if (jj > pb) x = -1.0f; v[i] = x; }
        *(LAS f32x4*)((LAS float*)(lds + L_ISUM) + (size_t)pos * 32 + 4 * jq) = v;
    }
    asm volatile("s_waitcnt lgkmcnt(0)\n\ts_barrier" ::: "memory");
    {
        const int pos = tid >> 3, jq = tid & 7;
        const LAS float* sp = (const LAS float*)(lds + L_ISUM) + (size_t)pos * 32;
        const f32x4 mine = *(const LAS f32x4*)(sp + 4 * jq);
        int rk0 = 0, rk1 = 0, rk2 = 0, rk3 = 0; const int j0 = 4 * jq;
#pragma unroll 4
        for (int c = 0; c < 32; ++c) { const float a = sp[c];
            rk0 += (a > mine[0] || (a == mine[0] && c < j0)) ? 1 : 0; rk1 += (a > mine[1] || (a == mine[1] && c < j0 + 1)) ? 1 : 0;
            rk2 += (a > mine[2] || (a == mine[2] && c < j0 + 2)) ? 1 : 0; rk3 += (a > mine[3] || (a == mine[3] && c < j0 + 3)) ? 1 : 0; }
        unsigned bits = (rk0 < 16 ? 1u : 0u) | (rk1 < 16 ? 2u : 0u) | (rk2 < 16 ? 4u : 0u) | (rk3 < 16 ? 8u : 0u); bits <<= j0;
        bits |= __shfl_xor(bits, 1); bits |= __shfl_xor(bits, 2); bits |= __shfl_xor(bits, 4);
        if (jq == 0) ((LAS unsigned*)(lds + L_MASK))[pos] = bits;
    }
    asm volatile("s_waitcnt lgkmcnt(0)\n\ts_barrier" ::: "memory");
    {
        const f32x2* rp = ROPE + (size_t)qpos * 32;
#pragma unroll
        for (int d0 = 0; d0 < 4; ++d0) {
            const u32x4 w = __builtin_bit_cast(u32x4, qr[d0]); u32x4 wo;
#pragma unroll
            for (int i = 0; i < 4; ++i) { const f32x2 cs = rp[8 * d0 + 4 * hi + i]; const float x1 = bf_lo(w[i]), x2 = bf_hi(w[i]);
                wo[i] = pk2(x1 * cs.x - x2 * cs.y, x2 * cs.x + x1 * cs.y); }
            qr[d0] = __builtin_bit_cast(bf16x8, wo);
        }
        asm volatile("" : "+v"(qr[0]), "+v"(qr[1]), "+v"(qr[2]), "+v"(qr[3]));
    }
    const unsigned upto = pb >= 31 ? 0xffffffffu : ((1u << (pb + 1)) - 1u);
#ifndef NO_SLC
    {
        const LAS unsigned* mk = (const LAS unsigned*)(lds + L_MASK);
        const unsigned rowmask = mk[ph * 32 + r32] & upto;
        unsigned un = mk[lane];
#pragma unroll
        for (int o_ = 1; o_ < 64; o_ <<= 1) un |= __shfl_xor(un, o_);
        un = (unsigned)__builtin_amdgcn_readfirstlane(un) & upto;
        KVSrc src{PROJ + rowbase * NPROJ + C_KS + g * 64, PROJ + rowbase * NPROJ + C_VS + g * 64, NPROJ, SEQ};
        f32x16 o[2], lacc;
        flash_sweep<1>(lds, src, qr, o, lacc, un, qpos, q0, q0 + 31, rowmask, nullptr, 0.f, wid, lane, true);
        f32x4 a[4]; load_rowfac(a, ws, g1, r32, hi);
#pragma unroll
        for (int r = 0; r < 16; ++r) lacc[r] = lacc[r] > 0.f ? a[r >> 2][r & 3] * __builtin_amdgcn_rcpf(lacc[r]) : 0.f;
        acc_tile<false>(tl, o, lacc, r32, hi);
    }
#endif
#ifndef NO_WIN
    {
        const int tlo = pb - 8 < 0 ? 0 : pb - 8;
        const unsigned tiles = upto & ~((1u << tlo) - 1u);
        KVSrc src{PROJ + rowbase * NPROJ + C_KW + g * 64, PROJ + rowbase * NPROJ + C_VW + g * 64, NPROJ, SEQ};
        f32x16 o[2], lacc;
        flash_sweep<2>(lds, src, qr, o, lacc, tiles, qpos, q0, q0 + 31, 0u, nullptr, 0.f, wid, lane);
        f32x4 a[4]; load_rowfac(a, ws, g2, r32, hi);
#pragma unroll
        for (int r = 0; r < 16; ++r) lacc[r] = lacc[r] > 0.f ? a[r >> 2][r & 3] * __builtin_amdgcn_rcpf(lacc[r]) : 0.f;
        acc_tile<false>(tl, o, lacc, r32, hi);
    }
#endif
    store_tile(tl, AO + (rowbase + q0) * DM + 512 + hd * 64, DM, lane);
}
}

constexpr int NWAVES = 8;
constexpr int LDS_BYTES = 147456;
constexpr int NPHASE = 16;

struct Args {
    const float* in[23]; float* out; unsigned char* ws; int ph_lo, ph_hi;
};

__device__ __forceinline__ int win_src(int j) {
    if (j < 1536) return j;
    if (j < 2048) { const int t = j - 1536, h = t >> 6, jj = t & 63; return 1544 + h * 64 + (jj >> 1) + 32 * (jj & 1); }
    if (j < 2176) return 2056 + (j - 2048);
    if (j < 2304) return 2184 + (j - 2176);
    if (j < 2432) { const int t = j - 2304, h = t >> 6, jj = t & 63; return 2312 + h * 64 + (jj >> 1) + 32 * (jj & 1); }
    if (j < 2560) return 2440 + (j - 2432);
    if (j < 2688) { const int t = j - 2560, h = t >> 6, jj = t & 63; return 2568 + h * 64 + (jj >> 1) + 32 * (jj & 1); }
    if (j < 2816) return 2696 + (j - 2688);
    if (j < 2824) return 1536 + (j - 2816);
    if (j < 2848) return j;
    return -1;
}
template <bool MAPPED>
__device__ __forceinline__ void transpose_item(const float* W, int K, int N, bf16_t* WT, int ndest, LAS float* scr, int item, int lane, const float* kgain = nullptr) {
    const int nblk = ndest / 32, kb = item / nblk, nb = item % nblk, k0 = 64 * kb, n0 = 32 * nb;
    const int sc = MAPPED ? win_src(n0 + (lane & 31)) : (n0 + (lane & 31));
#pragma unroll 8
    for (int i = 0; i < 32; ++i) { const int kk = 2 * i + (lane >> 5); float w = sc >= 0 ? W[(size_t)(k0 + kk) * N + sc] : 0.f; if (kgain) w *= kgain[k0 + kk]; scr[kk * 33 + (lane & 31)] = w; }
    asm volatile("s_waitcnt lgkmcnt(0)" ::: "memory");
    const int c = lane & 7;
#pragma unroll
    for (int j = 0; j < 4; ++j) { const int n = (lane >> 3) + 8 * j; const LAS float* s = scr + (8 * c) * 33 + n;
        u32x4 o; o.x = pk2(s[0 * 33], s[1 * 33]); o.y = pk2(s[2 * 33], s[3 * 33]); o.z = pk2(s[4 * 33], s[5 * 33]); o.w = pk2(s[6 * 33], s[7 * 33]);
        *(u32x4*)(WT + (size_t)(n0 + n) * K + k0 + 8 * c) = o; }
    asm volatile("s_waitcnt lgkmcnt(0)" ::: "memory");
}
template <int R>
__device__ __forceinline__ void rms_rows_to_bf16(const float* x0, const float* g, bf16_t* o0, int lane) {
    f32x4 v[R][4];
#pragma unroll
    for (int r = 0; r < R; ++r) { const f32x4* xr = (const f32x4*)(x0 + (size_t)r * 1024) + lane;
#pragma unroll
        for (int j = 0; j < 4; ++j) v[r][j] = xr[64 * j]; }
    const f32x4* gr = (const f32x4*)g + lane; f32x4 gg[4];
#pragma unroll
    for (int j = 0; j < 4; ++j) gg[j] = gr[64 * j];
#pragma unroll
    for (int r = 0; r < R; ++r) { float s = 0.f;
#pragma unroll
        for (int j = 0; j < 4; ++j) s += (v[r][j].x * v[r][j].x + v[r][j].y * v[r][j].y) + (v[r][j].z * v[r][j].z + v[r][j].w * v[r][j].w);
        const float rstd = 1.0f / sqrtf(wave_sum(s) * (1.f / 1024.f) + RMS_EPS);
        u32x2* o8 = (u32x2*)(o0 + (size_t)r * 1024) + lane;
#pragma unroll
        for (int j = 0; j < 4; ++j) { u32x2 w; w.x = pk2(v[r][j].x * rstd * gg[j].x, v[r][j].y * rstd * gg[j].y); w.y = pk2(v[r][j].z * rstd * gg[j].z, v[r][j].w * rstd * gg[j].w); o8[64 * j] = w; } }
}
template <bool NEXT, int R, bool HIN_BF, bool HOUT_BF>
__device__ __forceinline__ void residual_rows(const void* hres, const bf16_t* y, const float* gpost, void* hout, float* rstd_out, int lane) {
    u32x2 yw[R][4]; f32x4 hv[R][4];
#pragma unroll
    for (int r = 0; r < R; ++r) { const u32x2* yr = (const u32x2*)(y + (size_t)r * 1024) + lane;
#pragma unroll
        for (int j = 0; j < 4; ++j) yw[r][j] = yr[64 * j];
        if (HIN_BF) { const u32x2* hr = (const u32x2*)((const bf16_t*)hres + (size_t)r * 1024) + lane;
#pragma unroll
            for (int j = 0; j < 4; ++j) { const u32x2 w = hr[64 * j]; hv[r][j] = (f32x4){bf_lo(w.x), bf_hi(w.x), bf_lo(w.y), bf_hi(w.y)}; } }
        else { const f32x4* hr = (const f32x4*)((const float*)hres + (size_t)r * 1024) + lane;
#pragma unroll
            for (int j = 0; j < 4; ++j) hv[r][j] = hr[64 * j]; } }
    const f32x4* gp = (const f32x4*)gpost + lane; f32x4 g1[4];
#pragma unroll
    for (int j = 0; j < 4; ++j) g1[j] = gp[64 * j];
#pragma unroll
    for (int r = 0; r < R; ++r) { f32x4 yv[4]; float s = 0.f;
#pragma unroll
        for (int j = 0; j < 4; ++j) { const u32x2 w = yw[r][j]; yv[j] = (f32x4){bf_lo(w.x), bf_hi(w.x), bf_lo(w.y), bf_hi(w.y)}; s += (yv[j].x * yv[j].x + yv[j].y * yv[j].y) + (yv[j].z * yv[j].z + yv[j].w * yv[j].w); }
        const float rstd = 1.0f / sqrtf(wave_sum(s) * (1.f / 1024.f) + RMS_EPS); float s2 = 0.f;
#pragma unroll
        for (int j = 0; j < 4; ++j) { const f32x4 h = hv[r][j] + yv[j] * rstd * g1[j]; hv[r][j] = h; s2 += (h.x * h.x + h.y * h.y) + (h.z * h.z + h.w * h.w); }
        if (HOUT_BF) { u32x2* ho = (u32x2*)((bf16_t*)hout + (size_t)r * 1024) + lane;
#pragma unroll
            for (int j = 0; j < 4; ++j) { const f32x4 h = hv[r][j]; u32x2 w; w.x = pk2(h.x, h.y); w.y = pk2(h.z, h.w); ho[64 * j] = w; } }
        else { f32x4* ho = (f32x4*)((float*)hout + (size_t)r * 1024) + lane;
#pragma unroll
            for (int j = 0; j < 4; ++j) ho[64 * j] = hv[r][j]; }
        if (NEXT) { const float r2 = 1.0f / sqrtf(wave_sum(s2) * (1.f / 1024.f) + RMS_EPS); if (lane == 0) rstd_out[r] = r2;
        } }
}

struct KvMemOrder {
    int G, c;
    __device__ bool next(int i, pg8::Unit& u) const {
        const int L = i * G + c; if (L >= 256) return false;
        if (L < 128) { u.z = 0; u.pm = L >> 2; u.pn = L & 3; u.aoff = (size_t)u.pm * 256 * 1024 * 2; u.boff = (size_t)u.pn * 256 * 1024 * 2; u.coff = (size_t)u.pm * 256 * 1024 + u.pn * 256; }
        else { const int t = L - 128; u.z = 1; u.pm = t >> 5; u.pn = t & 31;
            u.aoff = (size_t)(WS_WXKV - WS_MN) + (size_t)(1024 + u.pm * 256) * 1024 * 2;
            u.boff = (size_t)(WS_MN - WS_WXKV) + (size_t)u.pn * 256 * 1024 * 2;
            u.coff = (size_t)(WS_VT - WS_KX) / 2 + (size_t)u.pm * 256 * 8192 + u.pn * 256; }
        return true;
    }
};
struct EpiKvMem {
    static constexpr bool PERM = true;
    bf16_t* O;
    __device__ __forceinline__ void operator()(const f32x4 (&acc)[2][2][4][2], const pg8::Unit& u, int wr, int wc, int fr, int fq) const {
        pg8::EpiBf16<0> e{O, u.z ? (size_t)8192 : (size_t)1024}; e(acc, u, wr, wc, fr, fq);
    }
};
struct CmpOrder {
    int G, c;
    __device__ bool next(int i, pg8::Unit& u) const {
        const int L = i * G + c; if (L >= 64) return false;
        u.z = L >> 4; u.pm = L & 15; u.pn = 0; const int g = u.z >> 1, kv = u.z & 1;
        u.aoff = ((size_t)u.pm * 256 * 16 * NPROJ + (kv ? C_VC : C_KC) + g * 64) * 2;
        u.boff = (size_t)kv * 256 * 1024 * 2;
        u.coff = (size_t)u.z * 4096 * 256 + (size_t)u.pm * 256 * 256;
        return true;
    }
};
struct XAttnOrder {
    int G, c; bool sv;
    __device__ bool next(int i, pg8::Unit& u) const {
        const int L = i * G + c; if (L >= 1024) return false;
        const int b = L >> 5, h = (L >> 3) & 3, rp = L & 7; u.z = 0; u.pm = b * 8 + rp; u.pn = h;
        u.aoff = ((size_t)u.pm * 256 * 1024 + h * 256) * 2;
        u.boff = sv ? ((size_t)h * 256 * 8192 + b * 256) * 2 : ((size_t)b * 256 * 1024 + h * 256) * 2;
        u.coff = (size_t)u.pm * 256 * 1024 + h * 256;
        return true;
    }
};


#define XB_TMO      128
#define XB_XCNT(j)  (256  + 64 * (j))
#define XB_XSUB(j)  (1280 + 64 * (j))
#define XB_XGEN(j)  (2304 + 64 * (j))
#define XB_TOP      3328
#define XB_TOPGEN   3392
#define XCD_BAR_WORDS 3456
#define XB_SPIN_CAP (1u << 18)
__device__ __forceinline__ unsigned xb_ld(unsigned* p)              { return __hip_atomic_load(p, __ATOMIC_RELAXED, __HIP_MEMORY_SCOPE_AGENT); }
__device__ __forceinline__ unsigned xb_add(unsigned* p, unsigned v) { return __hip_atomic_fetch_add(p, v, __ATOMIC_RELAXED, __HIP_MEMORY_SCOPE_AGENT); }
__device__ __forceinline__ unsigned xb_xcc_id() { return (unsigned)__builtin_amdgcn_s_getreg((3 << 11) | 20) & 0xFu; }
#define XB_SPIN(cond, bar) do { unsigned _sp = 0; while (cond) { __builtin_amdgcn_s_sleep(1); \
    if ((++_sp & 255u) == 0u) { if (xb_ld(&(bar)[XB_TMO])) break; if (_sp > XB_SPIN_CAP) { atomicAdd(&(bar)[XB_TMO], 1u); break; } } } } while (0)
__device__ __forceinline__ void xcd_barrier_complete(unsigned* bar, unsigned x, unsigned& nloc, unsigned& nx) {
    const unsigned G = gridDim.x * gridDim.y * gridDim.z;
    unsigned sum, cnt, mine, sp = 0u;
    for (;;) {
        sum = 0u; cnt = 0u; mine = 0u;
#pragma unroll
        for (unsigned j = 0; j < 16; ++j) { const unsigned c = xb_ld(&bar[XB_XCNT(j)]); sum += c; cnt += (c > 0u) ? 1u : 0u; mine = (j == x) ? c : mine; }
        if (sum == G) break;
        __builtin_amdgcn_s_sleep(1);
        if ((++sp & 255u) == 0u) { if (xb_ld(&bar[XB_TMO])) break; if (sp > XB_SPIN_CAP) { atomicAdd(&bar[XB_TMO], 1u); break; } }
    }
    nloc = mine > 0u ? mine : 1u; nx = cnt > 0u ? cnt : 1u;
}
__device__ __forceinline__ void xcd_barrier(unsigned* bar, unsigned x, volatile LAS unsigned* st, int tid) {
    asm volatile("s_waitcnt vmcnt(0)" ::: "memory");
    __syncthreads();
    if (tid == 0) {
        __builtin_amdgcn_s_waitcnt(0);
        unsigned nloc = st[0], nx = st[1];
        if (nloc == 0u) { xcd_barrier_complete(bar, x, nloc, nx); st[0] = nloc; st[1] = nx; }
        const unsigned old = xb_add(&bar[XB_XSUB(x)], 1u);
        const unsigned gen = old / nloc;
        if (old + 1u == (gen + 1u) * nloc) {
            __builtin_amdgcn_fence(__ATOMIC_RELEASE, "agent");
            asm volatile("s_waitcnt vmcnt(0)" ::: "memory");
            const unsigned og = xb_add(&bar[XB_TOP], 1u);
            const unsigned tg = og / nx;
            if (og + 1u == (tg + 1u) * nx) xb_add(&bar[XB_TOPGEN], 1u);
            else XB_SPIN(xb_ld(&bar[XB_TOPGEN]) == tg, bar);
            __builtin_amdgcn_fence(__ATOMIC_ACQUIRE, "agent");
            xb_add(&bar[XB_XGEN(x)], 1u);
            asm volatile("s_waitcnt vmcnt(0)" ::: "memory");
        } else {
            XB_SPIN(xb_ld(&bar[XB_XGEN(x)]) == gen, bar);
            __builtin_amdgcn_fence(__ATOMIC_ACQUIRE, "agent");
            asm volatile("s_waitcnt vmcnt(0)" ::: "memory");
        }
    }
    __syncthreads();
}
constexpr int CW_BAR = 4096;
constexpr int LDS_BARST = 143360;

__global__ void __launch_bounds__(NWAVES * 64, 2) layer_fwd(Args args) {
    extern __shared__ __attribute__((aligned(16))) unsigned char lds_raw[];
    LAS unsigned char* lds = (LAS unsigned char*)lds_raw;
    int wave_s = __builtin_amdgcn_readfirstlane((int)threadIdx.x >> 6);
    const int G = gridDim.x, bx = blockIdx.x;
    volatile LAS unsigned* barst = (volatile LAS unsigned*)(lds + LDS_BARST);
    unsigned xcc = 0u;
    if (args.ph_hi - args.ph_lo > 1) {
        if (threadIdx.x == 0) { barst[0] = 0u; barst[1] = 0u; }
        xcc = xb_xcc_id();
        if (threadIdx.x == 0) (void)xb_add((unsigned*)(args.ws + WS_CTL) + CW_BAR + XB_XCNT(xcc), 1u);
        __syncthreads();
    }
#define PHASE_IDS asm volatile("" : "+s"(wave_s)); auto kp_ = __builtin_amdgcn_kernarg_segment_ptr(); asm volatile("" : "+s"(kp_)); const Args* ap = (const Args*)kp_; unsigned char* const ws = ap->ws; (void)ws; const int wave = wave_s, lane = (int)__builtin_amdgcn_mbcnt_hi(~0u, __builtin_amdgcn_mbcnt_lo(~0u, 0u)), tid = wave * 64 + lane, gw = bx * NWAVES + wave, NGW = G * NWAVES; (void)tid; (void)gw; (void)NGW; (void)lane

#define INP(k) (ap->in[k])
#define x_ INP(0)
#define mem_ INP(1)
#define g_mix_pre INP(2)
#define w_in INP(3)
#define b_forget INP(4)
#define w_ck1 INP(5)
#define w_ck2 INP(6)
#define w_cv1 INP(7)
#define w_cv2 INP(8)
#define pe_k INP(9)
#define pe_v INP(10)
#define w_mix_out INP(11)
#define g_mix_post INP(12)
#define g_x_pre INP(13)
#define g_mem INP(14)
#define w_xq INP(15)
#define w_xkv INP(16)
#define w_xo INP(17)
#define g_x_post INP(18)
#define g_mlp_pre INP(19)
#define w_up INP(20)
#define w_down INP(21)
#define g_mlp_post INP(22)
#define OUTP (ap->out)
#define ctl ((unsigned*)(ws + WS_CTL))
#define WinT ((bf16_t*)(ws + WS_WIN))
#define WoutT ((bf16_t*)(ws + WS_WOUT))
#define WxqT ((bf16_t*)(ws + WS_WXQ))
#define WxkvT ((bf16_t*)(ws + WS_WXKV))
#define WxoT ((bf16_t*)(ws + WS_WXO))
#define WupT ((bf16_t*)(ws + WS_WUP))
#define WdnT ((bf16_t*)(ws + WS_WDN))
#define Wc1T ((bf16_t*)(ws + WS_WC1))
#define ROPE ((f32x2*)(ws + WS_ROPE))
#define BIAS1 ((float*)(ws + WS_BIAS1))
#define FG ((float*)(ws + WS_FG))
#define C2B ((float*)(ws + WS_C2))
#define Y ((float*)(ws + WS_Y))
#define KC ((bf16_t*)(ws + WS_KC))
#define MN ((bf16_t*)(ws + WS_MN))
#define KX ((bf16_t*)(ws + WS_KX))
#define VT ((bf16_t*)(ws + WS_VT))
#define NB ((bf16_t*)(ws + WS_N))
#define GB ((bf16_t*)(ws + WS_G))
#define AO ((bf16_t*)(ws + WS_AO))
#define PROJ ((bf16_t*)(ws + WS_PROJ))
#define QX ((bf16_t*)(ws + WS_QX))
#define SB ((float*)(ws + WS_S))
#define PB ((bf16_t*)(ws + WS_AO))
#define XOIN ((bf16_t*)(ws + WS_QX))
#define UB ((bf16_t*)(ws + WS_U))
#define H1B ((bf16_t*)(ws + WS_S))
#define RSTD2 ((float*)(ws + WS_Y))
#define RSTD3 ((float*)(ws + WS_Y + MiB))
#define XSB ((float*)(ws + WS_Y + 2 * MiB))
    const int lo = args.ph_lo, hi_ph = args.ph_hi;
#ifndef PHASE_MASK
#define PHASE_MASK 0xffff
#endif
#define IN(k) (((PHASE_MASK >> (k)) & 1) && lo <= (k) && (k) < hi_ph)
#define SEAM(k) do { if (lo <= (k) && (k) + (((k) == 5 || (k) == 8 || (k) == 11) ? 2 : 1) < hi_ph) { if ((k) == 0) cg::this_grid().sync(); else { PHASE_IDS; xcd_barrier(ctl + CW_BAR, xcc, barst, tid); } } } while (0)

    if (IN(0)) { PHASE_IDS;
        LAS float* scr = (LAS float*)(lds + wave * 16384);
        constexpr int I_IN = 16 * 96, I_SQ = 16 * 32, I_KV = 16 * 64, I_UP = 16 * 128, I_DN = 64 * 32, I_C1 = 16 * 4;
        constexpr int NITEMS = I_IN + 3 * I_SQ + I_KV + I_UP + I_DN + 4 * I_C1;
        for (int it = gw; it < NITEMS; it += NGW) {
            int r = it;
            if (r < I_IN) { transpose_item<true>(w_in, 1024, 2848, WinT, 3072, scr, r, lane); continue; } r -= I_IN;
            if (r < I_SQ) { transpose_item<false>(w_mix_out, 1024, 1024, WoutT, 1024, scr, r, lane); continue; } r -= I_SQ;
            if (r < I_SQ) { transpose_item<false>(w_xq, 1024, 1024, WxqT, 1024, scr, r, lane, g_x_pre); continue; } r -= I_SQ;
            if (r < I_SQ) { transpose_item<false>(w_xo, 1024, 1024, WxoT, 1024, scr, r, lane); continue; } r -= I_SQ;
            if (r < I_KV) { transpose_item<false>(w_xkv, 1024, 2048, WxkvT, 2048, scr, r, lane); continue; } r -= I_KV;
            if (r < I_UP) { transpose_item<false>(w_up, 1024, 4096, WupT, 4096, scr, r, lane, g_mlp_pre); continue; } r -= I_UP;
            if (r < I_DN) { transpose_item<false>(w_down, 4096, 1024, WdnT, 1024, scr, r, lane); continue; } r -= I_DN;
            { const int q = r / I_C1, rr = r % I_C1, kv = q >> 1, a = q & 1; const float* W1 = kv ? w_cv1 : w_ck1;
              transpose_item<false>(W1 + (size_t)a * 1024 * 128, 1024, 128, Wc1T + (size_t)kv * 256 * 1024 + (size_t)a * 128 * 1024, 128, scr, rr, lane); }
        }
        for (int m = gw * 4; m < MTOK; m += NGW * 4) rms_rows_to_bf16<4>(x_ + (size_t)m * DM, g_mix_pre, NB + (size_t)m * DM, lane);
        for (int m = gw * 4; m < MMEM; m += NGW * 4) rms_rows_to_bf16<4>(mem_ + (size_t)m * DM, g_mem, MN + (size_t)m * DM, lane);
        for (int i = bx * 512 + tid; i < SEQ * 32; i += G * 512) { const int pos = i >> 5, k = i & 31;
            const float inv = powf(10000.0f, -(float)k / 32.0f); const float ang = (float)pos * inv; float sn, cs; sincosf(ang, &sn, &cs); ROPE[i] = (f32x2){cs, sn}; }
        for (int o_ = gw; o_ < 256; o_ += NGW) { const int kv = o_ >> 7, c = o_ & 127; const float* W1 = kv ? w_cv1 : w_ck1; const float* pe = kv ? pe_v : pe_k; float s = 0.f;
            for (int kk = lane; kk < 2048; kk += 64) s += pe[kk] * W1[(size_t)kk * 128 + c];
            s = wave_sum(s); if (lane == 0) BIAS1[o_] = s; }
    }
    SEAM(0);
    if (IN(1)) { PHASE_IDS;
        { pg8::Gemm g{(const char*)NB, (const char*)WinT, 1024, 1024, 128, 128, 1024}; pg8::StaticOrder S; S.init(MTOK, NPROJ, G, bx, 1024, 1024, NPROJ);
          pg8::EpiProj E{PROJ, FG}; pg8::gemm_phase(lds, g, S, E, tid); }
        { pg8::Gemm g{(const char*)MN, (const char*)WxkvT, 1024, 1024, 128, 128, 1024}; KvMemOrder S{G, bx}; EpiKvMem E{KX}; pg8::gemm_phase(lds, g, S, E, tid); }
    }
    SEAM(1);
    if (IN(2)) { PHASE_IDS;
        const int nb = G > 64 ? 64 : 0;
        if (bx < 64 || nb == 0) {
            pg8::Gemm g{(const char*)PROJ, (const char*)Wc1T, 16 * NPROJ, 1024, NPROJ * 2, 128, 1024}; CmpOrder S{nb ? 64 : G, bx}; pg8::EpiF32 E{Y, 256, 1.0f};
            pg8::gemm_phase(lds, g, S, E, tid);
        }
        if (bx >= nb) {
            const int egw = (bx - nb) * NWAVES + wave, ENGW = (G - nb) * NWAVES;
            for (int s = egw; s < BATCH * 8; s += ENGW) { const int b = s >> 3, h = s & 7; const float bf = b_forget[h];
                const float* fp = FG + ((size_t)b * SEQ + lane * 32) * 32 + h; float v[32]; float run = 0.f;
#pragma unroll
                for (int i = 0; i < 32; ++i) { const float z = fp[(size_t)i * 32] + bf; const float ls = fminf(z, 0.f) - log1pf(expf(-fabsf(z))); run += ls; v[i] = run; }
                float incl = run;
#pragma unroll
                for (int o_ = 1; o_ < 64; o_ <<= 1) { const float t = __shfl_up(incl, o_); if (lane >= o_) incl += t; }
                const float excl = incl - run; float* cp = C2B + (size_t)s * SEQ + lane * 32;
#pragma unroll
                for (int i = 0; i < 32; ++i) cp[i] = (v[i] + excl) * att::LOG2E; }
            for (int tsk = egw; tsk < BATCH * 8 * 32; tsk += ENGW) { const int bh = tsk >> 5, ch = tsk & 31, b = bh >> 3, h = bh & 7;
                const bf16_t* base = PROJ + ((size_t)b * SEQ + ch * 64 + (lane >> 3)) * NPROJ + h * 64 + (lane & 7) * 8; float mq = 0.f, mk = 0.f;
#pragma unroll
                for (int p = 0; p < 8; ++p) { const u32x4 wq = *(const u32x4*)(base + (size_t)p * 8 * NPROJ + C_FQ), wk = *(const u32x4*)(base + (size_t)p * 8 * NPROJ + C_FK); float sq = 0.f, sk = 0.f;
#pragma unroll
                    for (int i = 0; i < 4; ++i) { const float a = bf_lo(wq[i]), c = bf_hi(wq[i]), d = bf_lo(wk[i]), e = bf_hi(wk[i]); sq += a * a + c * c; sk += d * d + e * e; }
                    sq += __shfl_xor(sq, 1); sq += __shfl_xor(sq, 2); sq += __shfl_xor(sq, 4); sk += __shfl_xor(sk, 1); sk += __shfl_xor(sk, 2); sk += __shfl_xor(sk, 4);
                    mq = fmaxf(mq, sq); mk = fmaxf(mk, sk); }
                mq = wave_max(mq); mk = wave_max(mk);
                if (lane == 0) { atomicMax(&ctl[CW_NORM + 2 * bh], __float_as_uint(mq)); atomicMax(&ctl[CW_NORM + 2 * bh + 1], __float_as_uint(mk)); } }
            for (int m = egw; m < MTOK; m += ENGW) { const int pos = m & (SEQ - 1); const int cl = 4 * (lane & 31);
                bf16_t* p = PROJ + (size_t)m * NPROJ + (lane < 32 ? C_KS : C_KW) + cl; const int i0 = (cl & 63) >> 1;
                const u32x2 w = *(const u32x2*)p; const f32x2 cs0 = ROPE[pos * 32 + i0], cs1 = ROPE[pos * 32 + i0 + 1]; u32x2 o;
                { const float x1 = bf_lo(w.x), x2 = bf_hi(w.x); o.x = pk2(x1 * cs0.x - x2 * cs0.y, x2 * cs0.x + x1 * cs0.y); }
                { const float x1 = bf_lo(w.y), x2 = bf_hi(w.y); o.y = pk2(x1 * cs1.x - x2 * cs1.y, x2 * cs1.x + x1 * cs1.y); }
                *(u32x2*)p = o; }
        }
    }
    SEAM(2);
    if (IN(3)) { PHASE_IDS;
        LAS float* hs = (LAS float*)(lds + wave * 512);
        for (int idx = gw; idx < 4 * BATCH * 128; idx += NGW) { const int z = idx >> 12, rem = idx & 4095, b = rem >> 7, n = rem & 127, g = z >> 1, kv = z & 1;
            bf16_t* dst = KC + (((size_t)(b * 2 + g) * 2 + kv) * 128 + n) * 64;
            if (n == 127) { dst[lane] = 0; continue; }
            const float* y0 = Y + ((size_t)z * 4096 + b * 128 + n) * 256; const float* y1 = y0 + 256 + 128;
#pragma unroll
            for (int q = 0; q < 2; ++q) { const int c = lane + 64 * q; const float a = y0[c] + y1[c] + BIAS1[kv * 128 + c]; hs[c] = a / (1.f + __expf(-a)); }
            asm volatile("s_waitcnt lgkmcnt(0)" ::: "memory");
            const float* W2 = kv ? w_cv2 : w_ck2; const int js = kv ? lane : ((lane >> 1) + 32 * (lane & 1)); float acc = 0.f;
#pragma unroll 8
            for (int c = 0; c < 128; ++c) acc += hs[c] * W2[c * 64 + js];
            dst[lane] = (bf16_t)(pk2(acc, 0.f) & 0xffffu);
            asm volatile("s_waitcnt lgkmcnt(0)" ::: "memory"); }
    }
    SEAM(3);
    if (IN(4)) { PHASE_IDS;
        LAS int* qw = (LAS int*)(lds + att::L_MISC);
        const int myq = (int)(xb_xcc_id() & 7u);
        for (int qi = 0; qi < 8; ++qi) {
            const int q = (myq + qi) & 7;
            for (;;) {
                if (tid == 0) qw[0] = (int)atomicAdd(&ctl[CW_QUEUE + 64 * q], 1u);
                __syncthreads();
                const int u = qw[0];
                __syncthreads();
                if (u >= 512) break;
                const int b = q + 8 * (u >> 7), r = u & 127;
                if (r < 64) att::nsa_unit(lds, b, r & 1, 31 - (r >> 1), PROJ, KC, FG, ROPE, AO, wave, lane);
                else { const int v = r - 64; att::fox_unit(lds, b, v & 7, 7 - (v >> 3), PROJ, C2B, (const float*)(ctl + CW_NORM + 2 * (b * 8 + (v & 7))), AO, wave, lane); }
            }
        }
    }
    SEAM(4);
    if (IN(5)) { PHASE_IDS; pg8::Gemm g{(const char*)AO, (const char*)WoutT, 1024, 1024, 128, 128, 1024}; pg8::StaticOrder S; S.init(MTOK, 1024, G, bx, 1024, 1024, 1024);
        pg8::EpiResid<false, true, true> E{x_, H1B, g_mix_post, RSTD2, XSB, ctl + CW_XCNT, lds + 131072}; pg8::gemm_phase(lds, g, S, E, tid); }
    SEAM(5);
    if (IN(7)) { PHASE_IDS; pg8::Gemm g{(const char*)H1B, (const char*)WxqT, 1024, 1024, 128, 128, 1024}; pg8::StaticOrder S; S.init(MTOK, 1024, G, bx, 1024, 1024, 1024);
        pg8::EpiBf16<0> E{QX, 1024, RSTD2}; pg8::gemm_phase(lds, g, S, E, tid); }
    SEAM(7);
    if (IN(8)) { PHASE_IDS; pg8::Gemm g{(const char*)QX, (const char*)KX, 1024, 1024, 128, 128, 256}; XAttnOrder S{G, bx, false};
        pg8::EpiSoftmax E{PB, 1024, 0.0625f * att::LOG2E, lds + 131072}; pg8::gemm_phase(lds, g, S, E, tid); }
    SEAM(8);
    if (IN(10)) { PHASE_IDS; pg8::Gemm g{(const char*)PB, (const char*)VT, 1024, 8192, 128, 128, 256}; XAttnOrder S{G, bx, true};
        pg8::EpiBf16<0> E{XOIN, 1024}; pg8::gemm_phase(lds, g, S, E, tid); }
    SEAM(10);
    if (IN(11)) { PHASE_IDS; pg8::Gemm g{(const char*)XOIN, (const char*)WxoT, 1024, 1024, 128, 128, 1024}; pg8::StaticOrder S; S.init(MTOK, 1024, G, bx, 1024, 1024, 1024);
        pg8::EpiResid<true, true, true> E{H1B, GB, g_x_post, RSTD3, XSB + (size_t)2 * MTOK * 4, ctl + CW_XCNT + 2 * 256 * 64, lds + 131072}; pg8::gemm_phase(lds, g, S, E, tid); }
    SEAM(11);
    if (IN(13)) { PHASE_IDS; pg8::Gemm g{(const char*)GB, (const char*)WupT, 1024, 1024, 128, 128, 1024}; pg8::StaticOrder S; S.init(MTOK, FF, G, bx, 1024, 1024, FF);
        pg8::EpiBf16<1> E{UB, FF, RSTD3}; pg8::gemm_phase(lds, g, S, E, tid); }
    SEAM(13);
    if (IN(14)) { PHASE_IDS; pg8::Gemm g{(const char*)UB, (const char*)WdnT, FF, FF, 128, 128, FF}; pg8::StaticOrder S; S.init(MTOK, 1024, G, bx, FF, FF, 1024);
        pg8::EpiResid<true, false, false> E{GB, OUTP, g_mlp_post, nullptr, XSB + (size_t)4 * MTOK * 4, ctl + CW_XCNT + 4 * 256 * 64, lds + 131072}; pg8::gemm_phase(lds, g, S, E, tid); }
#undef IN
#undef SEAM
}

extern "C" void kernel_launch(void* const* d_in, const int* in_sizes, int n_in, void* d_out, int out_size, void* d_ws, size_t ws_size, hipStream_t stream) {
    static int grid = 0;
    if (grid == 0) {
        if (n_in != 23 || out_size != MTOK * DM || ws_size < WS_END) { fprintf(stderr, "kernel_launch: unexpected problem (n_in %d, out %d, ws %zu)\n", n_in, out_size, ws_size); grid = -1; return; }
        int dev = 0, cus = 0, per_cu = 0;
        hipGetDevice(&dev); hipDeviceGetAttribute(&cus, hipDeviceAttributeMultiprocessorCount, dev);
        if (hipFuncSetAttribute((const void*)layer_fwd, hipFuncAttributeMaxDynamicSharedMemorySize, LDS_BYTES) != hipSuccess) { fprintf(stderr, "kernel_launch: hipFuncSetAttribute failed\n"); grid = -1; return; }
        if (hipOccupancyMaxActiveBlocksPerMultiprocessor(&per_cu, (const void*)layer_fwd, NWAVES * 64, LDS_BYTES) != hipSuccess || per_cu < 1) { fprintf(stderr, "kernel_launch: occupancy query says %d\n", per_cu); per_cu = 1; }
        (void)hipGetLastError();
        grid = cus;
    }
    if (grid < 0) return;
    if (hipMemsetAsync((char*)d_ws + WS_CTL, 0, 1 << 20, stream) != hipSuccess) { fprintf(stderr, "kernel_launch: memset failed\n"); return; }
    Args a{};
    for (int i = 0; i < 23; ++i) a.in[i] = (const float*)d_in[i];
    a.out = (float*)d_out; a.ws = (unsigned char*)d_ws;
#if MK_ONE_LAUNCH
    a.ph_lo = 0; a.ph_hi = NPHASE;
    void* kargs[] = {&a};
    hipError_t e = hipLaunchCooperativeKernel((const void*)layer_fwd, dim3(grid), dim3(NWAVES * 64), kargs, LDS_BYTES, stream);
    if (e != hipSuccess) fprintf(stderr, "kernel_launch: cooperative launch failed: %s (grid %d)\n", hipGetErrorString(e), grid);
#else
    for (int p = 0; p < NPHASE; ++p) { a.ph_lo = p; a.ph_hi = p + 1; hipLaunchKernelGGL(layer_fwd, dim3(grid), dim3(NWAVES * 64), LDS_BYTES, stream, a); }
#endif
}
```

```cpp
#include <hip/hip_runtime.h>
#include <hip/hip_cooperative_groups.h>
#include <cstdio>
#include <cstdint>
namespace cg = cooperative_groups;

#ifndef MK_ONE_LAUNCH
#define MK_ONE_LAUNCH 1
#endif

#define LAS __attribute__((address_space(3)))
typedef unsigned short bf16_t;
typedef short bf16x8 __attribute__((ext_vector_type(8)));
typedef short s16x4 __attribute__((ext_vector_type(4)));
typedef float f32x2 __attribute__((ext_vector_type(2)));
typedef float f32x4 __attribute__((ext_vector_type(4)));
typedef float f32x16 __attribute__((ext_vector_type(16)));
typedef unsigned u32x2 __attribute__((ext_vector_type(2)));
typedef unsigned u32x4 __attribute__((ext_vector_type(4)));
typedef int i32x4 __attribute__((ext_vector_type(4)));
typedef int i32x8 __attribute__((ext_vector_type(8)));

constexpr int BATCH = 32, SEQ = 2048, DM = 1024, MTOK = BATCH * SEQ;
constexpr int NPROJ = 3072;
constexpr int MEMLEN = 256, MMEM = BATCH * MEMLEN;
constexpr int FF = 4096;
constexpr float RMS_EPS = 1e-6f;
constexpr int WDN_SHIFT = 10; constexpr float WDN_SCALE = (float)(1 << WDN_SHIFT);
constexpr int C_FQ = 0, C_FK = 512, C_FV = 1024, C_NQ = 1536, C_KC = 2048, C_VC = 2176, C_KS = 2304, C_VS = 2432, C_KW = 2560, C_VW = 2688, C_FF = 2816, C_NG = 2824;

constexpr size_t MiB = 1u << 20;
constexpr size_t WS_CTL = 0;
constexpr size_t WS_WIN = 2 * MiB;
constexpr size_t WS_WOUT = 8 * MiB;
constexpr size_t WS_WXQ = 10 * MiB;
constexpr size_t WS_WXKV = 12 * MiB;
constexpr size_t WS_WXO = 16 * MiB;
constexpr size_t WS_WUP = 18 * MiB;
constexpr size_t WS_WDN = 26 * MiB;
constexpr size_t WS_WC1 = 34 * MiB;
constexpr size_t WS_ROPE = 36 * MiB;
constexpr size_t WS_BIAS1 = 37 * MiB;
constexpr size_t WS_FG = 40 * MiB;
constexpr size_t WS_C2 = 48 * MiB;
constexpr size_t WS_Y = 50 * MiB;
constexpr size_t WS_KC = 82 * MiB;
constexpr size_t WS_MN = 84 * MiB;
constexpr size_t WS_KX = 100 * MiB;
constexpr size_t WS_VT = 116 * MiB;
constexpr size_t WS_N = 132 * MiB;
constexpr size_t WS_G = 260 * MiB;
constexpr size_t WS_AO = 388 * MiB;
constexpr size_t WS_PROJ = 516 * MiB;
constexpr size_t WS_QX = 516 * MiB;
constexpr size_t WS_S = 644 * MiB;
constexpr size_t WS_U = 388 * MiB;
constexpr size_t WS_END = 900 * MiB;

constexpr int CW_QUEUE = 64;
constexpr int CW_XCNT = 16384;
constexpr int CW_NORM = 8192;

__device__ __forceinline__ unsigned pk2(float lo, float hi) {
    typedef __bf16 b2 __attribute__((ext_vector_type(2)));
    f32x2 v = {lo, hi}; b2 b = __builtin_convertvector(v, b2); return __builtin_bit_cast(unsigned, b);
}
__device__ __forceinline__ unsigned pk4_f8(float a, float b, float c, float d) {
    a = __builtin_amdgcn_fmed3f(a, -448.f, 448.f); b = __builtin_amdgcn_fmed3f(b, -448.f, 448.f); c = __builtin_amdgcn_fmed3f(c, -448.f, 448.f); d = __builtin_amdgcn_fmed3f(d, -448.f, 448.f);
    int w = __builtin_amdgcn_cvt_pk_fp8_f32(a, b, 0, false); w = __builtin_amdgcn_cvt_pk_fp8_f32(c, d, w, true); return (unsigned)w;
}
__device__ __forceinline__ float bf_lo(unsigned u) { return __uint_as_float(u << 16); }
__device__ __forceinline__ float bf_hi(unsigned u) { return __uint_as_float(u & 0xffff0000u); }
__device__ __forceinline__ float wave_sum(float v) {
#pragma unroll
    for (int o = 1; o < 64; o <<= 1) v += __shfl_xor(v, o);
    return v;
}
__device__ __forceinline__ float wave_max(float v) {
#pragma unroll
    for (int o = 1; o < 64; o <<= 1) v = fmaxf(v, __shfl_xor(v, o));
    return v;
}

namespace pg8 {
constexpr int BM = 256, BK = 64, HALF = 128, HTB = HALF * BK * 2, STAGE_BYTES = 8 * HTB, NXCD = 8, WGM = 4;

__host__ __device__ __forceinline__ int lds_byte(int r, int c) { const int st = (r >> 4) * 2 + (c >> 5), rr = r & 15, cc = c & 31, ob = rr * 64 + cc * 2; return st * 1024 + (ob ^ (((ob >> 9) & 1) << 5)); }
__host__ __device__ __forceinline__ void stage_rc(int b, int& R, int& C) { const int st = b / 1024, sb = b % 1024, swz = sb ^ (((sb >> 9) & 1) << 5); R = (st >> 1) * 16 + swz / 64; C = (st & 1) * 32 + (swz % 64) / 2; }
__host__ __device__ __forceinline__ int perm32(int rho) { const int n = rho >> 4, i = rho & 15; return 8 * (i >> 2) + 4 * n + (i & 3); }

struct Unit { int pm, pn, z; size_t aoff, boff, coff; };
struct Gemm { const char* A; const char* Bt; unsigned lda, ldb; unsigned kstepA, kstepB; int K; };

struct StaticOrder {
    int nM, nN, nwg, G, c; size_t lda, ldb, ldc;
    __device__ void init(int M, int N, int G_, int c_, size_t lda_, size_t ldb_, size_t ldc_) { nM = M / BM; nN = N / BM; nwg = nM * nN; G = G_; c = c_; lda = lda_; ldb = ldb_; ldc = ldc_; }
    __device__ bool next(int i, Unit& u) const {
        const long L = (long)i * G + c; if (L >= nwg) return false;
        int wgid = (int)L; { const int q = nwg / NXCD, r = nwg % NXCD, xcd = wgid % NXCD, off = wgid / NXCD; wgid = (xcd < r ? xcd * (q + 1) : r * (q + 1) + (xcd - r) * q) + off; }
        const int nig = WGM * nN, gid = wgid / nig, fm = gid * WGM, gsz = (nM - fm) < WGM ? (nM - fm) : WGM;
        u.pm = fm + ((wgid % nig) % gsz); u.pn = (wgid % nig) / gsz; u.z = 0;
        u.aoff = (size_t)u.pm * BM * lda * 2; u.boff = (size_t)u.pn * BM * ldb * 2; u.coff = (size_t)u.pm * BM * ldc + (size_t)u.pn * BM;
        return true;
    }
};

template <int ACT  > struct EpiBf16 {
    static constexpr bool PERM = true;
    bf16_t* O; size_t ldc; const float* rscale = nullptr;
    __device__ __forceinline__ void operator()(const f32x4 (&acc)[2][2][4][2], const Unit& u, int wr, int wc, int fr, int fq) const {
        bf16_t* base = O + u.coff + (size_t)(wr * 64 + fr) * ldc + wc * 32 + 8 * fq;
#pragma unroll
        for (int ai = 0; ai < 2; ++ai)
#pragma unroll
            for (int m = 0; m < 4; ++m) { bf16_t* rowp = base + (size_t)(ai * HALF + m * 16) * ldc;
                const float rs = rscale ? rscale[u.pm * BM + wr * 64 + fr + ai * HALF + m * 16] : 1.f;
#pragma unroll
                for (int bj = 0; bj < 2; ++bj) { f32x4 v0 = acc[ai][bj][m][0] * rs, v1 = acc[ai][bj][m][1] * rs;
                    if (ACT == 1) {
#pragma unroll
                        for (int i = 0; i < 4; ++i) { const float a = fmaxf(v0[i], 0.f), b = fmaxf(v1[i], 0.f); v0[i] = a * a; v1[i] = b * b; } }
                    u32x4 w; w.x = pk2(v0[0], v0[1]); w.y = pk2(v0[2], v0[3]); w.z = pk2(v1[0], v1[1]); w.w = pk2(v1[2], v1[3]);
                    *(u32x4*)(rowp + bj * HALF) = w; } }
    }
};
struct EpiF8Relu2 {
    static constexpr bool PERM = true;
    unsigned char* O; size_t ldc; const float* rscale;
    __device__ __forceinline__ void operator()(const f32x4 (&acc)[2][2][4][2], const Unit& u, int wr, int wc, int fr, int fq) const {
        unsigned char* base = O + u.coff + (size_t)(wr * 64 + fr) * ldc + wc * 32 + 8 * fq;
#pragma unroll
        for (int ai = 0; ai < 2; ++ai)
#pragma unroll
            for (int m = 0; m < 4; ++m) { unsigned char* rowp = base + (size_t)(ai * HALF + m * 16) * ldc;
                const float rs = rscale[u.pm * BM + wr * 64 + fr + ai * HALF + m * 16];
#pragma unroll
                for (int bj = 0; bj < 2; ++bj) { f32x4 v0 = acc[ai][bj][m][0] * rs, v1 = acc[ai][bj][m][1] * rs;
#pragma unroll
                    for (int i = 0; i < 4; ++i) { const float a = fmaxf(v0[i], 0.f), b = fmaxf(v1[i], 0.f); v0[i] = a * a; v1[i] = b * b; }
                    u32x2 w; w.x = pk4_f8(v0[0], v0[1], v0[2], v0[3]); w.y = pk4_f8(v1[0], v1[1], v1[2], v1[3]);
                    *(u32x2*)(rowp + bj * HALF) = w; } }
    }
};
struct EpiProj {
    static constexpr bool PERM = true;
    bf16_t* O; float* FG;
    __device__ __forceinline__ void operator()(const f32x4 (&acc)[2][2][4][2], const Unit& u, int wr, int wc, int fr, int fq) const {
        if (u.pn < 11) {
            bf16_t* base = O + u.coff + (size_t)(wr * 64 + fr) * NPROJ + wc * 32 + 8 * fq;
#pragma unroll
            for (int ai = 0; ai < 2; ++ai)
#pragma unroll
                for (int m = 0; m < 4; ++m) { bf16_t* rowp = base + (size_t)(ai * HALF + m * 16) * NPROJ;
#pragma unroll
                    for (int bj = 0; bj < 2; ++bj) { const f32x4 v0 = acc[ai][bj][m][0], v1 = acc[ai][bj][m][1];
                        u32x4 w; w.x = pk2(v0[0], v0[1]); w.y = pk2(v0[2], v0[3]); w.z = pk2(v1[0], v1[1]); w.w = pk2(v1[2], v1[3]);
                        *(u32x4*)(rowp + bj * HALF) = w; } }
        } else if (wc == 0) {
            float* base = FG + (size_t)(u.pm * BM + wr * 64 + fr) * 32 + 8 * fq;
#pragma unroll
            for (int ai = 0; ai < 2; ++ai)
#pragma unroll
                for (int m = 0; m < 4; ++m) { float* rowp = base + (size_t)(ai * HALF + m * 16) * 32;
                    *(f32x4*)(rowp) = acc[ai][0][m][0]; *(f32x4*)(rowp + 4) = acc[ai][0][m][1]; }
        }
    }
};
struct EpiF32 {
    static constexpr bool PERM = false;
    float* O; size_t ldc; float scale;
    __device__ __forceinline__ void operator()(const f32x4 (&acc)[2][2][4][2], const Unit& u, int wr, int wc, int fr, int fq) const {
        float* base = O + u.coff + (size_t)(wr * 64 + fr) * ldc + wc * 32 + 4 * fq;
#pragma unroll
        for (int ai = 0; ai < 2; ++ai)
#pragma unroll
            for (int m = 0; m < 4; ++m) { float* rowp = base + (size_t)(ai * HALF + m * 16) * ldc;
#pragma unroll
                for (int bj = 0; bj < 2; ++bj)
#pragma unroll
                    for (int n = 0; n < 2; ++n) *(f32x4*)(rowp + bj * HALF + n * 16) = acc[ai][bj][m][n] * scale; }
    }
};

struct EpiSoftmax {
    static constexpr bool PERM = true;
    bf16_t* O; size_t ldc; float scale; LAS unsigned char* xl;
    __device__ __forceinline__ void operator()(f32x4 (&acc)[2][2][4][2], const Unit& u, int wr, int wc, int fr, int fq) const {
        LAS f32x2* X = (LAS f32x2*)xl;
        float mown[2][4];
#pragma unroll
        for (int ai = 0; ai < 2; ++ai)
#pragma unroll
            for (int m = 0; m < 4; ++m) {
                float mx = -INFINITY;
#pragma unroll
                for (int bj = 0; bj < 2; ++bj)
#pragma unroll
                    for (int n = 0; n < 2; ++n) { const f32x4 v = acc[ai][bj][m][n]; mx = fmaxf(mx, fmaxf(fmaxf(v[0], v[1]), fmaxf(v[2], v[3]))); }
                mx = fmaxf(mx, __shfl_xor(mx, 16)); mx = fmaxf(mx, __shfl_xor(mx, 32));
                const float ms = mx * scale; float l = 0.f;
#pragma unroll
                for (int bj = 0; bj < 2; ++bj)
#pragma unroll
                    for (int n = 0; n < 2; ++n) { f32x4 v = acc[ai][bj][m][n];
#pragma unroll
                        for (int i = 0; i < 4; ++i) { v[i] = __builtin_amdgcn_exp2f(v[i] * scale - ms); l += v[i]; }
                        acc[ai][bj][m][n] = v; }
                l += __shfl_xor(l, 16); l += __shfl_xor(l, 32);
                mown[ai][m] = ms;
                if (fq == 0) X[(ai * HALF + wr * 64 + m * 16 + fr) * 4 + wc] = (f32x2){ms, l};
            }
        asm volatile("s_waitcnt lgkmcnt(0)" ::: "memory"); __builtin_amdgcn_s_barrier(); asm volatile("" ::: "memory");
        bf16_t* base = O + u.coff + (size_t)(wr * 64 + fr) * ldc + wc * 32 + 8 * fq;
#pragma unroll
        for (int ai = 0; ai < 2; ++ai)
#pragma unroll
            for (int m = 0; m < 4; ++m) {
                const LAS f32x4* xr = (const LAS f32x4*)(X + (ai * HALF + wr * 64 + m * 16 + fr) * 4);
                const f32x4 a = xr[0], b = xr[1];
                const float M = fmaxf(fmaxf(a[0], a[2]), fmaxf(b[0], b[2]));
                const float L = (a[1] * __builtin_amdgcn_exp2f(a[0] - M) + a[3] * __builtin_amdgcn_exp2f(a[2] - M)) + (b[1] * __builtin_amdgcn_exp2f(b[0] - M) + b[3] * __builtin_amdgcn_exp2f(b[2] - M));
                const float f = __builtin_amdgcn_exp2f(mown[ai][m] - M) / L;
                bf16_t* rowp = base + (size_t)(ai * HALF + m * 16) * ldc;
#pragma unroll
                for (int bj = 0; bj < 2; ++bj) { const f32x4 v0 = acc[ai][bj][m][0] * f, v1 = acc[ai][bj][m][1] * f;
                    u32x4 w; w.x = pk2(v0[0], v0[1]); w.y = pk2(v0[2], v0[3]); w.z = pk2(v1[0], v1[1]); w.w = pk2(v1[2], v1[3]);
                    *(u32x4*)(rowp + bj * HALF) = w; }
            }
        asm volatile("s_waitcnt lgkmcnt(0)" ::: "memory"); __builtin_amdgcn_s_barrier(); asm volatile("" ::: "memory");
    }
};

template <bool HIN_BF, bool HOUT_BF, bool NEXT, int ASHIFT = 0> struct EpiResid {
    static constexpr bool PERM = true;
    static constexpr float asc = 1.f / (float)(1 << ASHIFT);
    const void* hres; void* hout; const float* gpost; float* rstd_out; float* xs; unsigned* cnt; LAS unsigned char* xl;
    __device__ __forceinline__ void stats(const float (&part)[2][4], const Unit& u, int bank, int wr, int wc, int fr, int fq) const {
        LAS float* P = (LAS float*)xl;
        LAS float* S = (LAS float*)(xl + 4096);
        const int wid = wr * 4 + wc, lane = fq * 16 + fr;
#pragma unroll
        for (int ai = 0; ai < 2; ++ai)
#pragma unroll
            for (int m = 0; m < 4; ++m) { float v = part[ai][m]; v += __shfl_xor(v, 16); v += __shfl_xor(v, 32); if (fq == 0) P[(ai * HALF + wr * 64 + m * 16 + fr) * 4 + wc] = v; }
        asm volatile("s_waitcnt lgkmcnt(0)" ::: "memory"); __builtin_amdgcn_s_barrier(); asm volatile("" ::: "memory");
        const int row = wid * 32 + (lane & 31);
        unsigned* slot = (unsigned*)(xs + ((size_t)bank * MTOK + (size_t)u.pm * BM + row) * 4);
        if (lane < 32) { const f32x4 p = *(const LAS f32x4*)(P + row * 4); const float t = (p[0] + p[1]) + (p[2] + p[3]);
            __hip_atomic_store(slot + u.pn, __float_as_uint(t), __ATOMIC_RELAXED, __HIP_MEMORY_SCOPE_AGENT); }
        asm volatile("s_waitcnt vmcnt(0)" ::: "memory");
        unsigned* c = cnt + ((size_t)bank * 256 + u.pm) * 64;
        if (lane == 0) __hip_atomic_fetch_add(c, 1u, __ATOMIC_RELAXED, __HIP_MEMORY_SCOPE_AGENT);
        if (wid == 0) {
            for (unsigned sp = 0; sp < (1u << 17); ++sp) { if ((unsigned)__builtin_amdgcn_readfirstlane(__hip_atomic_load(c, __ATOMIC_RELAXED, __HIP_MEMORY_SCOPE_AGENT)) >= 32u) break; __builtin_amdgcn_s_sleep(2); }
        }
        asm volatile("s_waitcnt vmcnt(0) lgkmcnt(0)" ::: "memory"); __builtin_amdgcn_s_barrier(); asm volatile("" ::: "memory");
        if (lane < 32) { float tot = 0.f;
#pragma unroll
            for (int t = 0; t < 4; ++t) tot += __uint_as_float(__hip_atomic_load(slot + t, __ATOMIC_RELAXED, __HIP_MEMORY_SCOPE_AGENT));
            S[row] = 1.0f / sqrtf(tot * (1.f / 1024.f) + RMS_EPS); }
        asm volatile("s_waitcnt lgkmcnt(0)" ::: "memory"); __builtin_amdgcn_s_barrier(); asm volatile("" ::: "memory");
    }
    __device__ __forceinline__ void operator()(f32x4 (&acc)[2][2][4][2], const Unit& u, int wr, int wc, int fr, int fq) const {
        const LAS float* S = (const LAS float*)(xl + 4096);
        float part[2][4];
#pragma unroll
        for (int ai = 0; ai < 2; ++ai)
#pragma unroll
            for (int m = 0; m < 4; ++m) { float sq = 0.f;
#pragma unroll
                for (int bj = 0; bj < 2; ++bj)
#pragma unroll
                    for (int n = 0; n < 2; ++n) { const f32x4 v = acc[ai][bj][m][n]; sq += (v[0] * v[0] + v[1] * v[1]) + (v[2] * v[2] + v[3] * v[3]); }
                part[ai][m] = sq * (asc * asc); }
        const int col0 = u.pn * BM + wc * 32 + 8 * fq;
        constexpr int NPRE = HIN_BF ? 4 : 2;
        f32x4 pre[NPRE][2][2];
#pragma unroll
        for (int m = 0; m < NPRE; ++m) { const size_t off = (size_t)(u.pm * BM + wr * 64 + m * 16 + fr) * 1024 + col0;
#pragma unroll
            for (int bj = 0; bj < 2; ++bj) {
                if (HIN_BF) { const u32x4 w = *(const u32x4*)((const bf16_t*)hres + off + bj * HALF); pre[m][bj][0] = __builtin_bit_cast(f32x4, w); }
                else { pre[m][bj][0] = *(const f32x4*)((const float*)hres + off + bj * HALF); pre[m][bj][1] = *(const f32x4*)((const float*)hres + off + bj * HALF + 4); } } }
        stats(part, u, 0, wr, wc, fr, fq);
        f32x4 g[2][2];
#pragma unroll
        for (int bj = 0; bj < 2; ++bj) { g[bj][0] = *(const f32x4*)(gpost + col0 + bj * HALF); g[bj][1] = *(const f32x4*)(gpost + col0 + bj * HALF + 4); }
#pragma unroll
        for (int ai = 0; ai < 2; ++ai)
#pragma unroll
            for (int m = 0; m < 4; ++m) { const int rl = ai * HALF + wr * 64 + m * 16 + fr; const float rs = S[rl] * asc; const size_t off = (size_t)(u.pm * BM + rl) * 1024 + col0; float sq = 0.f;
#pragma unroll
                for (int bj = 0; bj < 2; ++bj) { f32x4 h0, h1;
                    if (HIN_BF) { u32x4 w; if (ai == 0 && m < NPRE) w = __builtin_bit_cast(u32x4, pre[m < NPRE ? m : 0][bj][0]); else w = *(const u32x4*)((const bf16_t*)hres + off + bj * HALF);
                        h0 = (f32x4){bf_lo(w.x), bf_hi(w.x), bf_lo(w.y), bf_hi(w.y)}; h1 = (f32x4){bf_lo(w.z), bf_hi(w.z), bf_lo(w.w), bf_hi(w.w)}; }
                    else { if (ai == 0 && m < NPRE) { h0 = pre[m < NPRE ? m : 0][bj][0]; h1 = pre[m < NPRE ? m : 0][bj][1]; } else { h0 = *(const f32x4*)((const float*)hres + off + bj * HALF); h1 = *(const f32x4*)((const float*)hres + off + bj * HALF + 4); } }
                    h0 += acc[ai][bj][m][0] * rs * g[bj][0]; h1 += acc[ai][bj][m][1] * rs * g[bj][1];
                    if (HOUT_BF) { u32x4 w; w.x = pk2(h0[0], h0[1]); w.y = pk2(h0[2], h0[3]); w.z = pk2(h1[0], h1[1]); w.w = pk2(h1[2], h1[3]); *(u32x4*)((bf16_t*)hout + off + bj * HALF) = w; }
                    else { *(f32x4*)((float*)hout + off + bj * HALF) = h0; *(f32x4*)((float*)hout + off + bj * HALF + 4) = h1; }
                    if (NEXT) sq += ((h0[0] * h0[0] + h0[1] * h0[1]) + (h0[2] * h0[2] + h0[3] * h0[3])) + ((h1[0] * h1[0] + h1[1] * h1[1]) + (h1[2] * h1[2] + h1[3] * h1[3])); }
                part[ai][m] = sq; }
        if (NEXT) {
            stats(part, u, 1, wr, wc, fr, fq);
            if (u.pn == 0 && wc == 0 && fq == 0) {
#pragma unroll
                for (int ai = 0; ai < 2; ++ai)
#pragma unroll
                    for (int m = 0; m < 4; ++m) { const int rl = ai * HALF + wr * 64 + m * 16 + fr; rstd_out[u.pm * BM + rl] = S[rl]; }
            }
            asm volatile("s_waitcnt lgkmcnt(0)" ::: "memory"); __builtin_amdgcn_s_barrier(); asm volatile("" ::: "memory");
        }
    }
};

__device__ __forceinline__ i32x8 cat8(const bf16x8& lo, const bf16x8& hi) { return __builtin_shufflevector(__builtin_bit_cast(i32x4, lo), __builtin_bit_cast(i32x4, hi), 0, 1, 2, 3, 4, 5, 6, 7); }
template <bool F8 = false, class Epi, class Sched>
__device__ __forceinline__ void gemm_phase(LAS unsigned char* lds, const Gemm g, const Sched& S, const Epi& E, const int tid) {
    const int wid = __builtin_amdgcn_readfirstlane(tid >> 6), lane = tid & 63, wr = wid >> 2, wc = wid & 3, fr = lane & 15, fq = lane >> 4;
    const int K = g.K, nt = K / BK;
    unsigned voffA[2], voffB[2];
#pragma unroll
    for (int i = 0; i < 2; ++i) { int R, C; stage_rc(tid * 16 + i * 8192, R, C); const int Rb = Epi::PERM ? ((R & ~31) + perm32(R & 31)) : R;
        voffA[i] = (unsigned)(R * g.lda + C) * 2u; voffB[i] = (unsigned)(Rb * g.ldb + C) * 2u; }
    const size_t kstepA = g.kstepA, kstepB = g.kstepB;
    const size_t hstepA = (size_t)HALF * g.lda * 2, hstepB = (size_t)HALF * g.ldb * 2;
    const unsigned ldsw = (unsigned)wid * 1024u;
    const int aoff = lds_byte(wr * 64 + fr, fq * 8), boff = lds_byte(wc * 32 + fr, fq * 8);
#define PG8_SA(b, h) (((b) * 2 + (h)) * HTB)
#define PG8_SB(b, h) ((4 + (b) * 2 + (h)) * HTB)
#define PG8_STAGE(bufoff, gbase, voff) do { _Pragma("unroll") for (int _i = 0; _i < 2; ++_i) \
        __builtin_amdgcn_global_load_lds((const unsigned*)((const char*)(gbase) + (voff)[_i]), (LAS unsigned*)(lds + (bufoff) + ldsw + _i * 8192), 16, 0, 0); } while (0)
#define PG8_LDA(dst, b, h) do { _Pragma("unroll") for (int m = 0; m < 4; ++m) _Pragma("unroll") for (int k = 0; k < 2; ++k) dst[m][k] = *(const LAS bf16x8*)(lds + PG8_SA(b, h) + aoff + m * 2048 + k * 1024); } while (0)
#define PG8_LDB(dst, b, h) do { _Pragma("unroll") for (int n = 0; n < 2; ++n) _Pragma("unroll") for (int k = 0; k < 2; ++k) dst[n][k] = *(const LAS bf16x8*)(lds + PG8_SB(b, h) + boff + n * 2048 + k * 1024); } while (0)
#define PG8_MMA(ai, bj, At, Bt) do { __builtin_amdgcn_s_setprio(1); _Pragma("unroll") for (int m = 0; m < 4; ++m) _Pragma("unroll") for (int n = 0; n < 2; ++n) { \
        if (F8) asm volatile("v_mfma_f32_16x16x128_f8f6f4 %0, %1, %2, %0" : "+v"(acc[ai][bj][m][n]) : "v"(cat8(Bt[n][0], Bt[n][1])), "v"(cat8(At[m][0], At[m][1]))); \
        else { _Pragma("unroll") for (int k = 0; k < 2; ++k) acc[ai][bj][m][n] = __builtin_amdgcn_mfma_f32_16x16x32_bf16(Bt[n][k], At[m][k], acc[ai][bj][m][n], 0, 0, 0); } } __builtin_amdgcn_s_setprio(0); } while (0)
#define PG8_WAIT_V(n) asm volatile("s_waitcnt vmcnt(" #n ")" ::: "memory")
#define PG8_WAIT_L(n) asm volatile("s_waitcnt lgkmcnt(" #n ")" ::: "memory")
#define PG8_BAR __builtin_amdgcn_s_barrier()
#define PG8_SCHED __builtin_amdgcn_sched_barrier(0)
    Unit cur, nxt; int ui = 0;
    if (!S.next(0, cur)) return;
    f32x4 acc[2][2][4][2];
#pragma unroll
    for (int a = 0; a < 2; ++a)
#pragma unroll
        for (int b = 0; b < 2; ++b)
#pragma unroll
            for (int m = 0; m < 4; ++m)
#pragma unroll
                for (int n = 0; n < 2; ++n) acc[a][b][m][n] = (f32x4){0.f, 0.f, 0.f, 0.f};
    bf16x8 At[4][2], B0[2][2], B1[2][2];
    const char* cA = g.A + cur.aoff; const char* cB = g.Bt + cur.boff;
    PG8_STAGE(PG8_SB(0, 0), cB, voffB); PG8_STAGE(PG8_SB(0, 1), cB + hstepB, voffB); PG8_STAGE(PG8_SA(0, 0), cA, voffA); PG8_STAGE(PG8_SA(0, 1), cA + hstepA, voffA);
    if (wr == 1) PG8_BAR;
    PG8_WAIT_V(2); PG8_BAR;
    PG8_STAGE(PG8_SB(1, 0), cB + kstepB, voffB); PG8_STAGE(PG8_SA(1, 0), cA + kstepA, voffA); PG8_STAGE(PG8_SB(1, 1), cB + hstepB + kstepB, voffB);
    PG8_WAIT_V(6); PG8_BAR;
    for (;;) {
        const bool has_next = S.next(ui + 1, nxt);
        const char* nA = has_next ? g.A + nxt.aoff : cA; const char* nB = has_next ? g.Bt + nxt.boff : cB;
        for (int t = 0; t < nt; t += 2) {
            const bool last = (t == nt - 2);
            const char* a1 = cA + (size_t)(t + 1) * kstepA;
            const char* a2 = last ? nA : cA + (size_t)(t + 2) * kstepA; const char* b2 = last ? nB : cB + (size_t)(t + 2) * kstepB;
            const char* a3 = a2 + kstepA; const char* b3 = b2 + kstepB;
            PG8_LDB(B0, 0, 0); PG8_LDB(B1, 0, 1); PG8_SCHED; PG8_LDA(At, 0, 0); PG8_STAGE(PG8_SA(1, 1), a1 + hstepA, voffA);
            PG8_WAIT_V(8); PG8_WAIT_L(0); PG8_BAR; PG8_MMA(0, 0, At, B0); PG8_MMA(0, 1, At, B1); PG8_BAR; PG8_SCHED;
            PG8_LDA(At, 0, 1); PG8_STAGE(PG8_SB(0, 0), b2, voffB); PG8_STAGE(PG8_SB(0, 1), b2 + hstepB, voffB); PG8_STAGE(PG8_SA(0, 0), a2, voffA);
            PG8_WAIT_V(8); PG8_WAIT_L(0); PG8_BAR; PG8_MMA(1, 0, At, B0); PG8_MMA(1, 1, At, B1); PG8_BAR; PG8_SCHED;
            PG8_LDB(B0, 1, 0); PG8_LDB(B1, 1, 1); PG8_SCHED; PG8_LDA(At, 1, 0); PG8_STAGE(PG8_SA(0, 1), a2 + hstepA, voffA);
            PG8_WAIT_V(8); PG8_WAIT_L(0); PG8_BAR; PG8_MMA(0, 0, At, B0); PG8_MMA(0, 1, At, B1); PG8_BAR; PG8_SCHED;
            PG8_LDA(At, 1, 1); PG8_STAGE(PG8_SB(1, 0), b3, voffB); PG8_STAGE(PG8_SB(1, 1), b3 + hstepB, voffB); PG8_STAGE(PG8_SA(1, 0), a3, voffA);
            PG8_WAIT_V(8); PG8_WAIT_L(0); PG8_BAR; PG8_MMA(1, 0, At, B0); PG8_MMA(1, 1, At, B1); PG8_BAR; PG8_SCHED;
        }
        if (F8) { asm volatile("s_nop 15\n\ts_nop 15" ::: "memory"); PG8_SCHED; }
        if (wr == 0) PG8_BAR;
        { int fr_e = fr, fq_e = fq; asm volatile("" : "+v"(fr_e), "+v"(fq_e));
          E(acc, cur, wr, wc, fr_e, fq_e); }
        if (!has_next) break;
#pragma unroll
        for (int a = 0; a < 2; ++a)
#pragma unroll
            for (int b = 0; b < 2; ++b)
#pragma unroll
                for (int m = 0; m < 4; ++m)
#pragma unroll
                    for (int n = 0; n < 2; ++n) acc[a][b][m][n] = (f32x4){0.f, 0.f, 0.f, 0.f};
        cur = nxt; cA = nA; cB = nB; ++ui;
        if (wr == 1) PG8_BAR;
    }
    PG8_WAIT_V(0);
    PG8_BAR;
#undef PG8_SA
#undef PG8_SB
#undef PG8_STAGE
#undef PG8_LDA
#undef PG8_LDB
#undef PG8_MMA
#undef PG8_WAIT_V
#undef PG8_WAIT_L
#undef PG8_BAR
#undef PG8_SCHED
}
}

namespace att {
constexpr float LOG2E = 1.4426950408889634f;
constexpr float C2 = 0.125f * LOG2E;
constexpr float THR = 8.f;
constexpr int L_KV = 0;
constexpr int L_IMP = 32768;
constexpr int L_CK = 65536;
constexpr int L_WS = 66560;
constexpr int L_OST = 68608;
constexpr int L_ISUM = 134144;
constexpr int L_MASK = 142336;
constexpr int L_MISC = 142592;

struct KVSrc { const bf16_t* k; const bf16_t* v; int pitch; int nrows; };

__device__ __forceinline__ void glds16(const void* gsrc, unsigned lds_dst) { unsigned keep;
    asm volatile("s_mov_b32 %0, m0\n\ts_mov_b32 m0, %2\n\ts_nop 0\n\tglobal_load_lds_dwordx4 %1, off\n\ts_mov_b32 m0, %0" : "=&s"(keep) : "v"(gsrc), "s"(lds_dst) : "memory"); }
__device__ __forceinline__ void glds4(const void* gsrc, unsigned lds_dst) { unsigned keep;
    asm volatile("s_mov_b32 %0, m0\n\ts_mov_b32 m0, %2\n\ts_nop 0\n\tglobal_load_lds_dword %1, off\n\ts_mov_b32 m0, %0" : "=&s"(keep) : "v"(gsrc), "s"(lds_dst) : "memory"); }
#define WAIT_BAR(N) asm volatile("s_waitcnt vmcnt(" #N ") lgkmcnt(0)\n\ts_barrier" ::: "memory")
__device__ __forceinline__ void dma_tile(LAS unsigned char* lds, int stage, const KVSrc& s, int key0, int wid, int lane) {
    const unsigned base = (unsigned)(unsigned long long)(lds + L_KV) + (unsigned)(stage * 16384 + wid * 1024);
    int kr = key0 + lane; kr = kr < 0 ? 0 : (kr >= s.nrows ? s.nrows - 1 : kr);
    const bf16_t* ks = s.k + (size_t)kr * s.pitch + wid * 8;
    glds16(ks, (unsigned)__builtin_amdgcn_readfirstlane(base));
    int vr = key0 + 16 * (wid & 3) + (lane >> 2); vr = vr < 0 ? 0 : (vr >= s.nrows ? s.nrows - 1 : vr);
    const bf16_t* vs = s.v + (size_t)vr * s.pitch + (wid >> 2) * 32 + (lane & 3) * 8;
    glds16(vs, (unsigned)__builtin_amdgcn_readfirstlane(base + 8192u));
}

__device__ __forceinline__ void qkt(f32x16& p0, f32x16& p1, const LAS unsigned char* Kslot, const bf16x8 (&qr)[4], const f32x16& c0, const f32x16& c1, int r32, int hi) {
    const LAS unsigned char* kb = Kslot + hi * 1024 + r32 * 16;
    f32x16 a, b;
    { const bf16x8 b0 = *(const LAS bf16x8*)(kb), b1 = *(const LAS bf16x8*)(kb + 512);
      a = __builtin_amdgcn_mfma_f32_32x32x16_bf16(b0, qr[0], c0, 0, 0, 0); b = __builtin_amdgcn_mfma_f32_32x32x16_bf16(b1, qr[0], c1, 0, 0, 0); }
#pragma unroll
    for (int d0 = 1; d0 < 4; ++d0) {
        const bf16x8 b0 = *(const LAS bf16x8*)(kb + d0 * 2048);
        const bf16x8 b1 = *(const LAS bf16x8*)(kb + d0 * 2048 + 512);
        a = __builtin_amdgcn_mfma_f32_32x32x16_bf16(b0, qr[d0], a, 0, 0, 0);
        b = __builtin_amdgcn_mfma_f32_32x32x16_bf16(b1, qr[d0], b, 0, 0, 0);
    }
    p0 = a; p1 = b;
}
typedef short v4i16_t __attribute__((ext_vector_type(4)));
__device__ __forceinline__ s16x4 vtr(const LAS unsigned char* p) { return __builtin_bit_cast(s16x4, __builtin_amdgcn_ds_read_tr16_b64_v4i16((LAS v4i16_t*)p)); }
__device__ __forceinline__ void pv(f32x16 (&o)[2], f32x16& lacc, const LAS unsigned char* Vslot, const bf16x8 (&pa)[4], int lane, int hi) {
    const LAS unsigned char* vp = Vslot + ((lane >> 4) & 1) * 32 + (lane & 3) * 8 + (4 * hi + ((lane & 15) >> 2)) * 64;
    const bf16x8 ones = {16256, 16256, 16256, 16256, 16256, 16256, 16256, 16256};
#pragma unroll
    for (int ks = 0; ks < 4; ++ks) {
#pragma unroll
        for (int d0 = 0; d0 < 2; ++d0) {
            const s16x4 lo = vtr(vp + d0 * 4096 + ks * 1024), hh = vtr(vp + d0 * 4096 + ks * 1024 + 512);
            const bf16x8 vf = {lo[0], lo[1], lo[2], lo[3], hh[0], hh[1], hh[2], hh[3]};
            o[d0] = __builtin_amdgcn_mfma_f32_32x32x16_bf16(pa[ks], vf, o[d0], 0, 0, 0);
        }
        lacc = __builtin_amdgcn_mfma_f32_32x32x16_bf16(pa[ks], ones, lacc, 0, 0, 0);
    }
}
__device__ __forceinline__ bf16x8 pack8(const f32x16& p, int b) {
    u32x4 w; w.x = pk2(p[b], p[b + 1]); w.y = pk2(p[b + 2], p[b + 3]); w.z = pk2(p[b + 4], p[b + 5]); w.w = pk2(p[b + 6], p[b + 7]);
    return __builtin_bit_cast(bf16x8, w);
}
__device__ __forceinline__ float max3f(float a, float b, float c) { float r; asm("v_max3_f32 %0, %1, %2, %3" : "=v"(r) : "v"(a), "v"(b), "v"(c)); return r; }
__device__ __forceinline__ float max2f(float a, float b) { float r; asm("v_max_f32_e32 %0, %1, %2" : "=v"(r) : "v"(a), "v"(b)); return r; }
__device__ __forceinline__ float rowmax(const f32x16& p0, const f32x16& p1) {
    float a = max3f(p0[0], p0[1], p1[0]), b = max3f(p0[2], p0[3], p1[1]); a = max3f(a, p1[2], p1[3]);
#pragma unroll
    for (int r = 4; r < 16; r += 4) { a = max3f(a, p0[r], p0[r + 1]); b = max3f(b, p0[r + 2], p0[r + 3]); a = max3f(a, p1[r], p1[r + 1]); b = max3f(b, p1[r + 2], p1[r + 3]); }
    const float m = max2f(a, b);
    return max2f(m, __shfl_xor(m, 32));
}
__device__ __forceinline__ void load_rowfac(f32x4 (&a)[4], LAS float* ws, float f, int r32, int hi) {
    asm volatile("" ::: "memory");
    if (hi == 0) ws[r32] = f;
    asm volatile("s_waitcnt lgkmcnt(0)" ::: "memory");
#pragma unroll
    for (int k4 = 0; k4 < 4; ++k4) a[k4] = *(const LAS f32x4*)(ws + 8 * k4 + 4 * hi);
    asm volatile("s_waitcnt lgkmcnt(0)" ::: "memory");
}

template <int MODE>
__device__ __forceinline__ void flash_sweep(LAS unsigned char* lds, const KVSrc& src, const bf16x8 (&qr)[4], f32x16 (&o)[2], f32x16& lacc,
                                            unsigned tiles, int qpos, int wq_min, int wq_max, unsigned rowmask, const float* ck2, float cq2,
                                            int wid, int lane, const bool first_issued = false) {
    const int r32 = lane & 31, hi = lane >> 5;
    LAS float* ws = (LAS float*)(lds + L_WS + wid * 256);
    f32x16 negm;
#pragma unroll
    for (int r = 0; r < 16; ++r) { o[0][r] = 0.f; o[1][r] = 0.f; lacc[r] = 0.f; negm[r] = 0.f; }
    float mhat = 0.f; bool fresh = true;
    unsigned ri = tiles, rc = tiles; int issued = 0, it = 0;
    const unsigned ckbase = (unsigned)(unsigned long long)(lds + L_CK);
    if (first_issued) { ri &= ri - 1; issued = 1; }
#pragma unroll 1
    for (int k = issued; k < 3 && ri; ++k) { const int jn = __builtin_ctz(ri); ri &= ri - 1; dma_tile(lds, issued & 3, src, 64 * jn, wid, lane);
        if (MODE == 0 && wid == 0) glds4(ck2 + 64 * jn + lane, (unsigned)__builtin_amdgcn_readfirstlane(ckbase + (issued & 3) * 256)); ++issued; }
#pragma unroll 1
    while (rc) {
        const int j = __builtin_ctz(rc); rc &= rc - 1;
        const int ahead = issued - it - 1, st = it & 3;
        if (MODE == 0 && wid == 0) { if (ahead >= 2) WAIT_BAR(6); else if (ahead == 1) WAIT_BAR(3); else WAIT_BAR(0); }
        else { if (ahead >= 2) WAIT_BAR(4); else if (ahead == 1) WAIT_BAR(2); else WAIT_BAR(0); }
        if (ri) { const int jn = __builtin_ctz(ri); ri &= ri - 1; dma_tile(lds, issued & 3, src, 64 * jn, wid, lane);
            if (MODE == 0 && wid == 0) glds4(ck2 + 64 * jn + lane, (unsigned)__builtin_amdgcn_readfirstlane(ckbase + (issued & 3) * 256)); ++issued; }
        ++it;
        const int k0 = 64 * j;
        const bool skip = (k0 > wq_max) || (MODE == 2 && k0 + 63 <= wq_min - 512);
        if (!skip) {
            const LAS unsigned char* Ks = lds + L_KV + st * 16384;
            f32x16 p0, p1;
            if (MODE == 0) {
                const LAS float* ckp = (const LAS float*)(lds + L_CK + st * 256);
                const float base = cq2 - mhat; f32x16 c0v, c1v;
#pragma unroll
                for (int k4 = 0; k4 < 4; ++k4) { const f32x4 c0 = *(const LAS f32x4*)(ckp + 8 * k4 + 4 * hi), c1 = *(const LAS f32x4*)(ckp + 32 + 8 * k4 + 4 * hi);
#pragma unroll
                    for (int i = 0; i < 4; ++i) { c0v[4 * k4 + i] = base - c0[i]; c1v[4 * k4 + i] = base - c1[i]; } }
                qkt(p0, p1, Ks, qr, c0v, c1v, r32, hi);
            } else qkt(p0, p1, Ks, qr, negm, negm, r32, hi);
            const int qrel = qpos - k0 - 4 * hi;
            if (k0 + 63 > wq_min) {
                asm volatile("" ::: "memory");
#pragma unroll
                for (int r = 0; r < 16; ++r) { const int c = (r & 3) + 8 * (r >> 2); if (c > qrel) p0[r] = -INFINITY; if (c + 32 > qrel) p1[r] = -INFINITY; }
            }
            if (MODE == 2 && k0 <= wq_max - 512) {
                asm volatile("" ::: "memory");
#pragma unroll
                for (int r = 0; r < 16; ++r) { const int c = (r & 3) + 8 * (r >> 2); if (c <= qrel - 512) p0[r] = -INFINITY; if (c + 32 <= qrel - 512) p1[r] = -INFINITY; }
            }
            if (MODE == 1) {
                if (!__all((rowmask >> j) & 1u)) {
                    asm volatile("" ::: "memory");
                    const bool dead = !((rowmask >> j) & 1u);
#pragma unroll
                    for (int r = 0; r < 16; ++r) { if (dead) { p0[r] = -INFINITY; p1[r] = -INFINITY; } }
                }
            }
            const float rm = rowmax(p0, p1);
            const bool need = fresh ? (rm > -INFINITY) : (rm > THR);
            if (__any(need)) {
                asm volatile("" ::: "memory");
                const float dl = need ? (fresh ? rm : fmaxf(rm, 0.f)) : 0.f;
                const float alpha = fresh ? 1.f : __builtin_amdgcn_exp2f(-dl);
                mhat += dl; fresh = fresh && !need;
#pragma unroll
                for (int r = 0; r < 16; ++r) { p0[r] -= dl; p1[r] -= dl; negm[r] = -mhat; }
                f32x4 a[4]; load_rowfac(a, ws, alpha, r32, hi);
#pragma unroll
                for (int k4 = 0; k4 < 4; ++k4)
#pragma unroll
                    for (int i = 0; i < 4; ++i) { o[0][4 * k4 + i] *= a[k4][i]; o[1][4 * k4 + i] *= a[k4][i]; lacc[4 * k4 + i] *= a[k4][i]; }
            }
#pragma unroll
            for (int r = 0; r < 16; ++r) { p0[r] = __builtin_amdgcn_exp2f(p0[r]); p1[r] = __builtin_amdgcn_exp2f(p1[r]); }
            bf16x8 pa[4]; pa[0] = pack8(p0, 0); pa[1] = pack8(p0, 8); pa[2] = pack8(p1, 0); pa[3] = pack8(p1, 8);
            pv(o, lacc, Ks + 8192, pa, lane, hi);
        }
    }
    WAIT_BAR(0);
}

__device__ __forceinline__ void store_o(LAS unsigned char* lds, const f32x16 (&o)[2], const f32x16& fac, bf16_t* Ow, size_t pitch, int wid, int lane) {
    const int r32 = lane & 31, hi = lane >> 5;
    LAS bf16_t* stg = (LAS bf16_t*)(lds + L_OST + wid * 4096);
#pragma unroll
    for (int r = 0; r < 16; ++r) { const int orow = (r & 3) + 8 * (r >> 2) + 4 * hi;
#pragma unroll
        for (int d0 = 0; d0 < 2; ++d0) { const unsigned w = pk2(o[d0][r] * fac[r], 0.f); stg[orow * 64 + d0 * 32 + r32] = (bf16_t)(w & 0xffffu); } }
    asm volatile("s_waitcnt lgkmcnt(0)" ::: "memory");
#pragma unroll
    for (int i = 0; i < 4; ++i) { const int row = i * 8 + (lane >> 3), ch = lane & 7; const u32x4 v = *(const LAS u32x4*)(stg + row * 64 + ch * 8); *(u32x4*)(Ow + (size_t)row * pitch + ch * 8) = v; }
    asm volatile("s_waitcnt lgkmcnt(0)" ::: "memory");
}


template <bool FIRST>
__device__ __forceinline__ void acc_tile(LAS float* tl, const f32x16 (&o)[2], const f32x16& fac, int r32, int hi) {
#pragma unroll
    for (int r = 0; r < 16; ++r) { const int orow = (r & 3) + 8 * (r >> 2) + 4 * hi; const float f = fac[r];
#pragma unroll
        for (int d0 = 0; d0 < 2; ++d0) { LAS float* p = tl + orow * 64 + d0 * 32 + r32; if (FIRST) *p = o[d0][r] * f; else *p += o[d0][r] * f; } }
}
__device__ __forceinline__ void store_tile(const LAS float* tl, bf16_t* Ow, size_t pitch, int lane) {
    asm volatile("s_waitcnt lgkmcnt(0)" ::: "memory");
#pragma unroll
    for (int i = 0; i < 4; ++i) { const int row = i * 8 + (lane >> 3), ch = lane & 7; const f32x4 v0 = *(const LAS f32x4*)(tl + row * 64 + ch * 8), v1 = *(const LAS f32x4*)(tl + row * 64 + ch * 8 + 4);
        u32x4 w; w.x = pk2(v0[0], v0[1]); w.y = pk2(v0[2], v0[3]); w.z = pk2(v1[0], v1[1]); w.w = pk2(v1[2], v1[3]); *(u32x4*)(Ow + (size_t)row * pitch + ch * 8) = w; }
    asm volatile("s_waitcnt lgkmcnt(0)" ::: "memory");
}

__device__ __forceinline__ bf16x8 scale_q(bf16x8 q) {
    const u32x4 w = __builtin_bit_cast(u32x4, q); u32x4 o;
#pragma unroll
    for (int i = 0; i < 4; ++i) o[i] = pk2(bf_lo(w[i]) * C2, bf_hi(w[i]) * C2);
    return __builtin_bit_cast(bf16x8, o);
}
__device__ __forceinline__ void fox_unit(LAS unsigned char* lds, int b, int h, int qb, const bf16_t* PROJ, const float* C2buf, const float* nrm, bf16_t* AO, int wid, int lane) {
    const int r32 = lane & 31, hi = lane >> 5;
    const size_t rowbase = (size_t)b * SEQ;
    const int q0 = qb * 256 + wid * 32, qpos = q0 + r32;
    const bf16_t* Qp = PROJ + (rowbase + qpos) * NPROJ + C_FQ + h * 64;
    bf16x8 qr[4];
#pragma unroll
    for (int d0 = 0; d0 < 4; ++d0) qr[d0] = scale_q(*(const bf16x8*)(Qp + d0 * 16 + hi * 8));
    const float* ck2 = C2buf + ((size_t)b * 8 + h) * SEQ;
    float cq2 = ck2[qpos];
    asm volatile("" : "+v"(qr[0]), "+v"(qr[1]), "+v"(qr[2]), "+v"(qr[3]), "+v"(cq2));
    KVSrc src{PROJ + rowbase * NPROJ + C_FK + h * 64, PROJ + rowbase * NPROJ + C_FV + h * 64, NPROJ, SEQ};
    const int nt = 4 * qb + 4;
    unsigned tiles = nt >= 32 ? 0xffffffffu : ((1u << nt) - 1u);
    {
        const float smax = C2 * sqrtf(nrm[0]) * sqrtf(nrm[1]) * 1.01f + 0.01f;
        const int kt = lane < 32 ? lane : 31; const float dec = ck2[64 * kt + 63] - ck2[qb * 256];
        const unsigned keep = (unsigned)__ballot(dec <= 2.f * smax + 40.f);
        tiles &= keep | (0xfu << (4 * qb));
    }
    f32x16 o[2], lacc;
    flash_sweep<0>(lds, src, qr, o, lacc, tiles, qpos, q0, q0 + 31, 0u, ck2, cq2, wid, lane);
#pragma unroll
    for (int r = 0; r < 16; ++r) lacc[r] = __builtin_amdgcn_rcpf(lacc[r]);
    store_o(lds, o, lacc, AO + (rowbase + q0) * DM + h * 64, DM, wid, lane);
}

__device__ __forceinline__ void nsa_unit(LAS unsigned char* lds, int b, int g, int pb, const bf16_t* PROJ, const bf16_t* KC, const float* FG, const f32x2* ROPE, bf16_t* AO, int wid, int lane) {
    const int tid = wid * 64 + lane, r32 = lane & 31, hi = lane >> 5;
    const int hr = wid & 3, ph = wid >> 2, hd = 4 * g + hr;
    const size_t rowbase = (size_t)b * SEQ;
    const int q0 = pb * 64 + ph * 32, qpos = q0 + r32;
    LAS float* ws = (LAS float*)(lds + L_WS + wid * 256);
    const bf16_t* Qp = PROJ + (rowbase + qpos) * NPROJ + C_NQ + hd * 64;
    bf16x8 qr[4];
#pragma unroll
    for (int d0 = 0; d0 < 4; ++d0) qr[d0] = scale_q(*(const bf16x8*)(Qp + d0 * 16 + hi * 8));
    const float* gp = FG + (rowbase + qpos) * 32 + 8 + hd * 3;
    float g0 = 1.f / (1.f + __expf(-gp[0])), g1 = 1.f / (1.f + __expf(-gp[1])), g2 = 1.f / (1.f + __expf(-gp[2]));
    LAS float* tl = (LAS float*)(lds + L_OST + wid * 8192);
    {
        const bf16_t* kc = KC + ((size_t)(b * 2 + g) * 2 + 0) * 128 * 64; const bf16_t* vc = kc + 128 * 64;
        KVSrc csrc{kc, vc, 64, 128};
        dma_tile(lds, 0, csrc, 0, wid, lane); dma_tile(lds, 1, csrc, 64, wid, lane);
        WAIT_BAR(0);
        asm volatile("" : "+v"(qr[0]), "+v"(qr[1]), "+v"(qr[2]), "+v"(qr[3]), "+v"(g0), "+v"(g1), "+v"(g2));
        f32x16 zero16, lc, sc[4];
#pragma unroll
        for (int r = 0; r < 16; ++r) { zero16[r] = 0.f; lc[r] = 0.f; }
        const int nthr = ((qpos - 31) >> 4) - 4 * hi;
        qkt(sc[0], sc[1], lds + L_KV, qr, zero16, zero16, r32, hi);
        qkt(sc[2], sc[3], lds + L_KV + 16384, qr, zero16, zero16, r32, hi);
        float m = -INFINITY;
#pragma unroll
        for (int tp = 0; tp < 4; ++tp)
#pragma unroll
            for (int r = 0; r < 16; ++r) { const int n = 32 * tp + (r & 3) + 8 * (r >> 2); float v = sc[tp][r]; if (n > nthr) v = -INFINITY; sc[tp][r] = v; m = fmaxf(m, v); }
        m = fmaxf(m, __shfl_xor(m, 32));
        const float ms = (m == -INFINITY) ? 0.f : m;
        float l = 0.f;
#pragma unroll
        for (int tp = 0; tp < 4; ++tp)
#pragma unroll
            for (int r = 0; r < 16; ++r) { sc[tp][r] = __builtin_amdgcn_exp2f(sc[tp][r] - ms); l += sc[tp][r]; }
        l += __shfl_xor(l, 32);
        const float inv = l > 0.f ? 1.f / l : 0.f;
        f32x16 o[2];
#pragma unroll
        for (int r = 0; r < 16; ++r) { o[0][r] = 0.f; o[1][r] = 0.f; }
        LAS float* impw = (LAS float*)(lds + L_IMP) + ((size_t)hr * 64 + ph * 32 + r32) * 33;
        float carry = 0.f;
#pragma unroll
        for (int tp = 0; tp < 4; ++tp) {
#pragma unroll
            for (int r = 0; r < 16; ++r) sc[tp][r] *= inv;
#pragma unroll
            for (int k = 0; k < 4; ++k) { const float G = (sc[tp][4 * k] + sc[tp][4 * k + 1]) + (sc[tp][4 * k + 2] + sc[tp][4 * k + 3]); const float pe = __shfl_xor(sc[tp][4 * k + 3], 32);
                impw[8 * tp + 2 * k + hi] = G + (hi ? pe : carry); carry = pe; }
        }
#pragma unroll
        for (int ti = 0; ti < 2; ++ti) {
            bf16x8 pa[4]; pa[0] = pack8(sc[2 * ti], 0); pa[1] = pack8(sc[2 * ti], 8); pa[2] = pack8(sc[2 * ti + 1], 0); pa[3] = pack8(sc[2 * ti + 1], 8);
            pv(o, lc, lds + L_KV + ti * 16384 + 8192, pa, lane, hi);
        }
        f32x4 a[4]; load_rowfac(a, ws, g0, r32, hi); f32x16 fac;
#pragma unroll
        for (int r = 0; r < 16; ++r) fac[r] = a[r >> 2][r & 3];
        acc_tile<true>(tl, o, fac, r32, hi);
    }
    asm volatile("s_waitcnt lgkmcnt(0)\n\ts_barrier" ::: "memory");
    {
        KVSrc s0{PROJ + rowbase * NPROJ + C_KS + g * 64, PROJ + rowbase * NPROJ + C_VS + g * 64, NPROJ, SEQ};
        dma_tile(lds, 0, s0, 0, wid, lane);
    }
    {
        const int pos = tid >> 3, jq = tid & 7;
        const LAS float* ip = (const LAS float*)(lds + L_IMP) + (size_t)pos * 33 + 4 * jq;
        f32x4 v;
#pragma unroll
        for (int i = 0; i < 4; ++i) v[i] = ((ip[i] + ip[64 * 33 + i]) + ip[2 * 64 * 33 + i]) + ip[3 * 64 * 33 + i];
#pragma unroll
        for (int i = 0; i < 4; ++i) { const int jj = 4 * jq + i; float x = v[i];
            if (jj == pb) x = 2.0e4f; else if (jj == 0 || jj == pb - 1) x = 1.0e4f;
            if (jj > pb) x = -1.0f; v[i] = x; }
        *(LAS f32x4*)((LAS float*)(lds + L_ISUM) + (size_t)pos * 32 + 4 * jq) = v;
    }
    asm volatile("s_waitcnt lgkmcnt(0)\n\ts_barrier" ::: "memory");
    {
        const int pos = tid >> 3, jq = tid & 7;
        const LAS float* sp = (const LAS float*)(lds + L_ISUM) + (size_t)pos * 32;
        const f32x4 mine = *(const LAS f32x4*)(sp + 4 * jq);
        int rk0 = 0, rk1 = 0, rk2 = 0, rk3 = 0; const int j0 = 4 * jq;
#pragma unroll 4
        for (int c = 0; c < 32; ++c) { const float a = sp[c];
            rk0 += (a > mine[0] || (a == mine[0] && c < j0)) ? 1 : 0; rk1 += (a > mine[1] || (a == mine[1] && c < j0 + 1)) ? 1 : 0;
            rk2 += (a > mine[2] || (a == mine[2] && c < j0 + 2)) ? 1 : 0; rk3 += (a > mine[3] || (a == mine[3] && c < j0 + 3)) ? 1 : 0; }
        unsigned bits = (rk0 < 16 ? 1u : 0u) | (rk1 < 16 ? 2u : 0u) | (rk2 < 16 ? 4u : 0u) | (rk3 < 16 ? 8u : 0u); bits <<= j0;
        bits |= __shfl_xor(bits, 1); bits |= __shfl_xor(bits, 2); bits |= __shfl_xor(bits, 4);
        if (jq == 0) ((LAS unsigned*)(lds + L_MASK))[pos] = bits;
    }
    asm volatile("s_waitcnt lgkmcnt(0)\n\ts_barrier" ::: "memory");
    {
        const f32x2* rp = ROPE + (size_t)qpos * 32;
#pragma unroll
        for (int d0 = 0; d0 < 4; ++d0) {
            const u32x4 w = __builtin_bit_cast(u32x4, qr[d0]); u32x4 wo;
#pragma unroll
            for (int i = 0; i < 4; ++i) { const f32x2 cs = rp[8 * d0 + 4 * hi + i]; const float x1 = bf_lo(w[i]), x2 = bf_hi(w[i]);
                wo[i] = pk2(x1 * cs.x - x2 * cs.y, x2 * cs.x + x1 * cs.y); }
            qr[d0] = __builtin_bit_cast(bf16x8, wo);
        }
        asm volatile("" : "+v"(qr[0]), "+v"(qr[1]), "+v"(qr[2]), "+v"(qr[3]));
    }
    const unsigned upto = pb >= 31 ? 0xffffffffu : ((1u << (pb + 1)) - 1u);
#ifndef NO_SLC
    {
        const LAS unsigned* mk = (const LAS unsigned*)(lds + L_MASK);
        const unsigned rowmask = mk[ph * 32 + r32] & upto;
        unsigned un = mk[lane];
#pragma unroll
        for (int o_ = 1; o_ < 64; o_ <<= 1) un |= __shfl_xor(un, o_);
        un = (unsigned)__builtin_amdgcn_readfirstlane(un) & upto;
        KVSrc src{PROJ + rowbase * NPROJ + C_KS + g * 64, PROJ + rowbase * NPROJ + C_VS + g * 64, NPROJ, SEQ};
        f32x16 o[2], lacc;
        flash_sweep<1>(lds, src, qr, o, lacc, un, qpos, q0, q0 + 31, rowmask, nullptr, 0.f, wid, lane, true);
        f32x4 a[4]; load_rowfac(a, ws, g1, r32, hi);
#pragma unroll
        for (int r = 0; r < 16; ++r) lacc[r] = lacc[r] > 0.f ? a[r >> 2][r & 3] * __builtin_amdgcn_rcpf(lacc[r]) : 0.f;
        acc_tile<false>(tl, o, lacc, r32, hi);
    }
#endif
#ifndef NO_WIN
    {
        const int tlo = pb - 8 < 0 ? 0 : pb - 8;
        const unsigned tiles = upto & ~((1u << tlo) - 1u);
        KVSrc src{PROJ + rowbase * NPROJ + C_KW + g * 64, PROJ + rowbase * NPROJ + C_VW + g * 64, NPROJ, SEQ};
        f32x16 o[2], lacc;
        flash_sweep<2>(lds, src, qr, o, lacc, tiles, qpos, q0, q0 + 31, 0u, nullptr, 0.f, wid, lane);
        f32x4 a[4]; load_rowfac(a, ws, g2, r32, hi);
#pragma unroll
        for (int r = 0; r < 16; ++r) lacc[r] = lacc[r] > 0.f ? a[r >> 2][r & 3] * __builtin_amdgcn_rcpf(lacc[r]) : 0.f;
        acc_tile<false>(tl, o, lacc, r32, hi);
    }
#endif
    store_tile(tl, AO + (rowbase + q0) * DM + 512 + hd * 64, DM, lane);
}
}

constexpr int NWAVES = 8;
constexpr int LDS_BYTES = 147456;
constexpr int NPHASE = 16;

struct Args {
    const float* in[23]; float* out; unsigned char* ws; int ph_lo, ph_hi;
};

__device__ __forceinline__ int win_src(int j) {
    if (j < 1536) return j;
    if (j < 2048) { const int t = j - 1536, h = t >> 6, jj = t & 63; return 1544 + h * 64 + (jj >> 1) + 32 * (jj & 1); }
    if (j < 2176) return 2056 + (j - 2048);
    if (j < 2304) return 2184 + (j - 2176);
    if (j < 2432) { const int t = j - 2304, h = t >> 6, jj = t & 63; return 2312 + h * 64 + (jj >> 1) + 32 * (jj & 1); }
    if (j < 2560) return 2440 + (j - 2432);
    if (j < 2688) { const int t = j - 2560, h = t >> 6, jj = t & 63; return 2568 + h * 64 + (jj >> 1) + 32 * (jj & 1); }
    if (j < 2816) return 2696 + (j - 2688);
    if (j < 2824) return 1536 + (j - 2816);
    if (j < 2848) return j;
    return -1;
}
template <bool MAPPED>
__device__ __forceinline__ void transpose_item(const float* W, int K, int N, bf16_t* WT, int ndest, LAS float* scr, int item, int lane, const float* kgain = nullptr) {
    const int nblk = ndest / 32, kb = item / nblk, nb = item % nblk, k0 = 64 * kb, n0 = 32 * nb;
    const int sc = MAPPED ? win_src(n0 + (lane & 31)) : (n0 + (lane & 31));
#pragma unroll 8
    for (int i = 0; i < 32; ++i) { const int kk = 2 * i + (lane >> 5); float w = sc >= 0 ? W[(size_t)(k0 + kk) * N + sc] : 0.f; if (kgain) w *= kgain[k0 + kk]; scr[kk * 33 + (lane & 31)] = w; }
    asm volatile("s_waitcnt lgkmcnt(0)" ::: "memory");
    const int c = lane & 7;
#pragma unroll
    for (int j = 0; j < 4; ++j) { const int n = (lane >> 3) + 8 * j; const LAS float* s = scr + (8 * c) * 33 + n;
        u32x4 o; o.x = pk2(s[0 * 33], s[1 * 33]); o.y = pk2(s[2 * 33], s[3 * 33]); o.z = pk2(s[4 * 33], s[5 * 33]); o.w = pk2(s[6 * 33], s[7 * 33]);
        *(u32x4*)(WT + (size_t)(n0 + n) * K + k0 + 8 * c) = o; }
    asm volatile("s_waitcnt lgkmcnt(0)" ::: "memory");
}
__device__ __forceinline__ void transpose_item_f8(const float* W, int K, int N, unsigned char* WT8, LAS float* scr, int item, int lane, float wscale) {
    const int nblk = N / 32, kb = item / nblk, nb = item % nblk, k0 = 64 * kb, n0 = 32 * nb;
#pragma unroll 8
    for (int i = 0; i < 32; ++i) { const int kk = 2 * i + (lane >> 5); scr[kk * 33 + (lane & 31)] = W[(size_t)(k0 + kk) * N + n0 + (lane & 31)] * wscale; }
    asm volatile("s_waitcnt lgkmcnt(0)" ::: "memory");
    const int c = lane & 7;
#pragma unroll
    for (int j = 0; j < 4; ++j) { const int n = (lane >> 3) + 8 * j; const LAS float* s = scr + (8 * c) * 33 + n;
        u32x2 o; o.x = pk4_f8(s[0 * 33], s[1 * 33], s[2 * 33], s[3 * 33]); o.y = pk4_f8(s[4 * 33], s[5 * 33], s[6 * 33], s[7 * 33]);
        *(u32x2*)(WT8 + (size_t)(n0 + n) * K + k0 + 8 * c) = o; }
    asm volatile("s_waitcnt lgkmcnt(0)" ::: "memory");
}
template <int R>
__device__ __forceinline__ void rms_rows_to_bf16(const float* x0, const float* g, bf16_t* o0, int lane) {
    f32x4 v[R][4];
#pragma unroll
    for (int r = 0; r < R; ++r) { const f32x4* xr = (const f32x4*)(x0 + (size_t)r * 1024) + lane;
#pragma unroll
        for (int j = 0; j < 4; ++j) v[r][j] = xr[64 * j]; }
    const f32x4* gr = (const f32x4*)g + lane; f32x4 gg[4];
#pragma unroll
    for (int j = 0; j < 4; ++j) gg[j] = gr[64 * j];
#pragma unroll
    for (int r = 0; r < R; ++r) { float s = 0.f;
#pragma unroll
        for (int j = 0; j < 4; ++j) s += (v[r][j].x * v[r][j].x + v[r][j].y * v[r][j].y) + (v[r][j].z * v[r][j].z + v[r][j].w * v[r][j].w);
        const float rstd = 1.0f / sqrtf(wave_sum(s) * (1.f / 1024.f) + RMS_EPS);
        u32x2* o8 = (u32x2*)(o0 + (size_t)r * 1024) + lane;
#pragma unroll
        for (int j = 0; j < 4; ++j) { u32x2 w; w.x = pk2(v[r][j].x * rstd * gg[j].x, v[r][j].y * rstd * gg[j].y); w.y = pk2(v[r][j].z * rstd * gg[j].z, v[r][j].w * rstd * gg[j].w); o8[64 * j] = w; } }
}
template <bool NEXT, int R, bool HIN_BF, bool HOUT_BF>
__device__ __forceinline__ void residual_rows(const void* hres, const bf16_t* y, const float* gpost, void* hout, float* rstd_out, int lane) {
    u32x2 yw[R][4]; f32x4 hv[R][4];
#pragma unroll
    for (int r = 0; r < R; ++r) { const u32x2* yr = (const u32x2*)(y + (size_t)r * 1024) + lane;
#pragma unroll
        for (int j = 0; j < 4; ++j) yw[r][j] = yr[64 * j];
        if (HIN_BF) { const u32x2* hr = (const u32x2*)((const bf16_t*)hres + (size_t)r * 1024) + lane;
#pragma unroll
            for (int j = 0; j < 4; ++j) { const u32x2 w = hr[64 * j]; hv[r][j] = (f32x4){bf_lo(w.x), bf_hi(w.x), bf_lo(w.y), bf_hi(w.y)}; } }
        else { const f32x4* hr = (const f32x4*)((const float*)hres + (size_t)r * 1024) + lane;
#pragma unroll
            for (int j = 0; j < 4; ++j) hv[r][j] = hr[64 * j]; } }
    const f32x4* gp = (const f32x4*)gpost + lane; f32x4 g1[4];
#pragma unroll
    for (int j = 0; j < 4; ++j) g1[j] = gp[64 * j];
#pragma unroll
    for (int r = 0; r < R; ++r) { f32x4 yv[4]; float s = 0.f;
#pragma unroll
        for (int j = 0; j < 4; ++j) { const u32x2 w = yw[r][j]; yv[j] = (f32x4){bf_lo(w.x), bf_hi(w.x), bf_lo(w.y), bf_hi(w.y)}; s += (yv[j].x * yv[j].x + yv[j].y * yv[j].y) + (yv[j].z * yv[j].z + yv[j].w * yv[j].w); }
        const float rstd = 1.0f / sqrtf(wave_sum(s) * (1.f / 1024.f) + RMS_EPS); float s2 = 0.f;
#pragma unroll
        for (int j = 0; j < 4; ++j) { const f32x4 h = hv[r][j] + yv[j] * rstd * g1[j]; hv[r][j] = h; s2 += (h.x * h.x + h.y * h.y) + (h.z * h.z + h.w * h.w); }
        if (HOUT_BF) { u32x2* ho = (u32x2*)((bf16_t*)hout + (size_t)r * 1024) + lane;
#pragma unroll
            for (int j = 0; j < 4; ++j) { const f32x4 h = hv[r][j]; u32x2 w; w.x = pk2(h.x, h.y); w.y = pk2(h.z, h.w); ho[64 * j] = w; } }
        else { f32x4* ho = (f32x4*)((float*)hout + (size_t)r * 1024) + lane;
#pragma unroll
            for (int j = 0; j < 4; ++j) ho[64 * j] = hv[r][j]; }
        if (NEXT) { const float r2 = 1.0f / sqrtf(wave_sum(s2) * (1.f / 1024.f) + RMS_EPS); if (lane == 0) rstd_out[r] = r2;
        } }
}

struct KvMemOrder {
    int G, c;
    __device__ bool next(int i, pg8::Unit& u) const {
        const int L = i * G + c; if (L >= 256) return false;
        if (L < 128) { u.z = 0; u.pm = L >> 2; u.pn = L & 3; u.aoff = (size_t)u.pm * 256 * 1024 * 2; u.boff = (size_t)u.pn * 256 * 1024 * 2; u.coff = (size_t)u.pm * 256 * 1024 + u.pn * 256; }
        else { const int t = L - 128; u.z = 1; u.pm = t >> 5; u.pn = t & 31;
            u.aoff = (size_t)(WS_WXKV - WS_MN) + (size_t)(1024 + u.pm * 256) * 1024 * 2;
            u.boff = (size_t)(WS_MN - WS_WXKV) + (size_t)u.pn * 256 * 1024 * 2;
            u.coff = (size_t)(WS_VT - WS_KX) / 2 + (size_t)u.pm * 256 * 8192 + u.pn * 256; }
        return true;
    }
};
struct EpiKvMem {
    static constexpr bool PERM = true;
    bf16_t* O;
    __device__ __forceinline__ void operator()(const f32x4 (&acc)[2][2][4][2], const pg8::Unit& u, int wr, int wc, int fr, int fq) const {
        pg8::EpiBf16<0> e{O, u.z ? (size_t)8192 : (size_t)1024}; e(acc, u, wr, wc, fr, fq);
    }
};
struct CmpOrder {
    int G, c;
    __device__ bool next(int i, pg8::Unit& u) const {
        const int L = i * G + c; if (L >= 64) return false;
        u.z = L >> 4; u.pm = L & 15; u.pn = 0; const int g = u.z >> 1, kv = u.z & 1;
        u.aoff = ((size_t)u.pm * 256 * 16 * NPROJ + (kv ? C_VC : C_KC) + g * 64) * 2;
        u.boff = (size_t)kv * 256 * 1024 * 2;
        u.coff = (size_t)u.z * 4096 * 256 + (size_t)u.pm * 256 * 256;
        return true;
    }
};
struct XAttnOrder {
    int G, c; bool sv;
    __device__ bool next(int i, pg8::Unit& u) const {
        const int L = i * G + c; if (L >= 1024) return false;
        const int b = L >> 5, h = (L >> 3) & 3, rp = L & 7; u.z = 0; u.pm = b * 8 + rp; u.pn = h;
        u.aoff = ((size_t)u.pm * 256 * 1024 + h * 256) * 2;
        u.boff = sv ? ((size_t)h * 256 * 8192 + b * 256) * 2 : ((size_t)b * 256 * 1024 + h * 256) * 2;
        u.coff = (size_t)u.pm * 256 * 1024 + h * 256;
        return true;
    }
};


#define XB_TMO      128
#define XB_XCNT(j)  (256  + 64 * (j))
#define XB_XSUB(j)  (1280 + 64 * (j))
#define XB_XGEN(j)  (2304 + 64 * (j))
#define XB_TOP      3328
#define XB_TOPGEN   3392
#define XCD_BAR_WORDS 3456
#define XB_SPIN_CAP (1u << 18)
__device__ __forceinline__ unsigned xb_ld(unsigned* p)              { return __hip_atomic_load(p, __ATOMIC_RELAXED, __HIP_MEMORY_SCOPE_AGENT); }
__device__ __forceinline__ unsigned xb_add(unsigned* p, unsigned v) { return __hip_atomic_fetch_add(p, v, __ATOMIC_RELAXED, __HIP_MEMORY_SCOPE_AGENT); }
__device__ __forceinline__ unsigned xb_xcc_id() { return (unsigned)__builtin_amdgcn_s_getreg((3 << 11) | 20) & 0xFu; }
#define XB_SPIN(cond, bar) do { unsigned _sp = 0; while (cond) { __builtin_amdgcn_s_sleep(1); \
    if ((++_sp & 255u) == 0u) { if (xb_ld(&(bar)[XB_TMO])) break; if (_sp > XB_SPIN_CAP) { atomicAdd(&(bar)[XB_TMO], 1u); break; } } } } while (0)
__device__ __forceinline__ void xcd_barrier_complete(unsigned* bar, unsigned x, unsigned& nloc, unsigned& nx) {
    const unsigned G = gridDim.x * gridDim.y * gridDim.z;
    unsigned sum, cnt, mine, sp = 0u;
    for (;;) {
        sum = 0u; cnt = 0u; mine = 0u;
#pragma unroll
        for (unsigned j = 0; j < 16; ++j) { const unsigned c = xb_ld(&bar[XB_XCNT(j)]); sum += c; cnt += (c > 0u) ? 1u : 0u; mine = (j == x) ? c : mine; }
        if (sum == G) break;
        __builtin_amdgcn_s_sleep(1);
        if ((++sp & 255u) == 0u) { if (xb_ld(&bar[XB_TMO])) break; if (sp > XB_SPIN_CAP) { atomicAdd(&bar[XB_TMO], 1u); break; } }
    }
    nloc = mine > 0u ? mine : 1u; nx = cnt > 0u ? cnt : 1u;
}
__device__ __forceinline__ void xcd_barrier(unsigned* bar, unsigned x, volatile LAS unsigned* st, int tid) {
    asm volatile("s_waitcnt vmcnt(0)" ::: "memory");
    __syncthreads();
    if (tid == 0) {
        __builtin_amdgcn_s_waitcnt(0);
        unsigned nloc = st[0], nx = st[1];
        if (nloc == 0u) { xcd_barrier_complete(bar, x, nloc, nx); st[0] = nloc; st[1] = nx; }
        const unsigned old = xb_add(&bar[XB_XSUB(x)], 1u);
        const unsigned gen = old / nloc;
        if (old + 1u == (gen + 1u) * nloc) {
            __builtin_amdgcn_fence(__ATOMIC_RELEASE, "agent");
            asm volatile("s_waitcnt vmcnt(0)" ::: "memory");
            const unsigned og = xb_add(&bar[XB_TOP], 1u);
            const unsigned tg = og / nx;
            if (og + 1u == (tg + 1u) * nx) xb_add(&bar[XB_TOPGEN], 1u);
            else XB_SPIN(xb_ld(&bar[XB_TOPGEN]) == tg, bar);
            __builtin_amdgcn_fence(__ATOMIC_ACQUIRE, "agent");
            xb_add(&bar[XB_XGEN(x)], 1u);
            asm volatile("s_waitcnt vmcnt(0)" ::: "memory");
        } else {
            XB_SPIN(xb_ld(&bar[XB_XGEN(x)]) == gen, bar);
            __builtin_amdgcn_fence(__ATOMIC_ACQUIRE, "agent");
            asm volatile("s_waitcnt vmcnt(0)" ::: "memory");
        }
    }
    __syncthreads();
}
constexpr int CW_BAR = 4096;
constexpr int LDS_BARST = 143360;

__global__ void __launch_bounds__(NWAVES * 64, 2) layer_fwd(Args args) {
    extern __shared__ __attribute__((aligned(16))) unsigned char lds_raw[];
    LAS unsigned char* lds = (LAS unsigned char*)lds_raw;
    int wave_s = __builtin_amdgcn_readfirstlane((int)threadIdx.x >> 6);
    const int G = gridDim.x, bx = blockIdx.x;
    volatile LAS unsigned* barst = (volatile LAS unsigned*)(lds + LDS_BARST);
    unsigned xcc = 0u;
    if (args.ph_hi - args.ph_lo > 1) {
        if (threadIdx.x == 0) { barst[0] = 0u; barst[1] = 0u; }
        xcc = xb_xcc_id();
        if (threadIdx.x == 0) (void)xb_add((unsigned*)(args.ws + WS_CTL) + CW_BAR + XB_XCNT(xcc), 1u);
        __syncthreads();
    }
#define PHASE_IDS asm volatile("" : "+s"(wave_s)); auto kp_ = __builtin_amdgcn_kernarg_segment_ptr(); asm volatile("" : "+s"(kp_)); const Args* ap = (const Args*)kp_; unsigned char* const ws = ap->ws; (void)ws; const int wave = wave_s, lane = (int)__builtin_amdgcn_mbcnt_hi(~0u, __builtin_amdgcn_mbcnt_lo(~0u, 0u)), tid = wave * 64 + lane, gw = bx * NWAVES + wave, NGW = G * NWAVES; (void)tid; (void)gw; (void)NGW; (void)lane

#define INP(k) (ap->in[k])
#define x_ INP(0)
#define mem_ INP(1)
#define g_mix_pre INP(2)
#define w_in INP(3)
#define b_forget INP(4)
#define w_ck1 INP(5)
#define w_ck2 INP(6)
#define w_cv1 INP(7)
#define w_cv2 INP(8)
#define pe_k INP(9)
#define pe_v INP(10)
#define w_mix_out INP(11)
#define g_mix_post INP(12)
#define g_x_pre INP(13)
#define g_mem INP(14)
#define w_xq INP(15)
#define w_xkv INP(16)
#define w_xo INP(17)
#define g_x_post INP(18)
#define g_mlp_pre INP(19)
#define w_up INP(20)
#define w_down INP(21)
#define g_mlp_post INP(22)
#define OUTP (ap->out)
#define ctl ((unsigned*)(ws + WS_CTL))
#define WinT ((bf16_t*)(ws + WS_WIN))
#define WoutT ((bf16_t*)(ws + WS_WOUT))
#define WxqT ((bf16_t*)(ws + WS_WXQ))
#define WxkvT ((bf16_t*)(ws + WS_WXKV))
#define WxoT ((bf16_t*)(ws + WS_WXO))
#define WupT ((bf16_t*)(ws + WS_WUP))
#define WdnT ((bf16_t*)(ws + WS_WDN))
#define Wc1T ((bf16_t*)(ws + WS_WC1))
#define ROPE ((f32x2*)(ws + WS_ROPE))
#define BIAS1 ((float*)(ws + WS_BIAS1))
#define FG ((float*)(ws + WS_FG))
#define C2B ((float*)(ws + WS_C2))
#define Y ((float*)(ws + WS_Y))
#define KC ((bf16_t*)(ws + WS_KC))
#define MN ((bf16_t*)(ws + WS_MN))
#define KX ((bf16_t*)(ws + WS_KX))
#define VT ((bf16_t*)(ws + WS_VT))
#define NB ((bf16_t*)(ws + WS_N))
#define GB ((bf16_t*)(ws + WS_G))
#define AO ((bf16_t*)(ws + WS_AO))
#define PROJ ((bf16_t*)(ws + WS_PROJ))
#define QX ((bf16_t*)(ws + WS_QX))
#define SB ((float*)(ws + WS_S))
#define PB ((bf16_t*)(ws + WS_AO))
#define XOIN ((bf16_t*)(ws + WS_QX))
#define UB ((bf16_t*)(ws + WS_U))
#define H1B ((bf16_t*)(ws + WS_S))
#define RSTD2 ((float*)(ws + WS_Y))
#define RSTD3 ((float*)(ws + WS_Y + MiB))
#define XSB ((float*)(ws + WS_Y + 2 * MiB))
    const int lo = args.ph_lo, hi_ph = args.ph_hi;
#ifndef PHASE_MASK
#define PHASE_MASK 0xffff
#endif
#define IN(k) (((PHASE_MASK >> (k)) & 1) && lo <= (k) && (k) < hi_ph)
#define SEAM(k) do { if (lo <= (k) && (k) + (((k) == 5 || (k) == 8 || (k) == 11) ? 2 : 1) < hi_ph) { if ((k) == 0) cg::this_grid().sync(); else { PHASE_IDS; xcd_barrier(ctl + CW_BAR, xcc, barst, tid); } } } while (0)

    if (IN(0)) { PHASE_IDS;
        LAS float* scr = (LAS float*)(lds + wave * 16384);
        constexpr int I_IN = 16 * 96, I_SQ = 16 * 32, I_KV = 16 * 64, I_UP = 16 * 128, I_DN = 64 * 32, I_C1 = 16 * 4;
        constexpr int NITEMS = I_IN + 3 * I_SQ + I_KV + I_UP + I_DN + 4 * I_C1;
        for (int it = gw; it < NITEMS; it += NGW) {
            int r = it;
            if (r < I_IN) { transpose_item<true>(w_in, 1024, 2848, WinT, 3072, scr, r, lane); continue; } r -= I_IN;
            if (r < I_SQ) { transpose_item<false>(w_mix_out, 1024, 1024, WoutT, 1024, scr, r, lane); continue; } r -= I_SQ;
            if (r < I_SQ) { transpose_item<false>(w_xq, 1024, 1024, WxqT, 1024, scr, r, lane, g_x_pre); continue; } r -= I_SQ;
            if (r < I_SQ) { transpose_item<false>(w_xo, 1024, 1024, WxoT, 1024, scr, r, lane); continue; } r -= I_SQ;
            if (r < I_KV) { transpose_item<false>(w_xkv, 1024, 2048, WxkvT, 2048, scr, r, lane); continue; } r -= I_KV;
            if (r < I_UP) { transpose_item<false>(w_up, 1024, 4096, WupT, 4096, scr, r, lane, g_mlp_pre); continue; } r -= I_UP;
            if (r < I_DN) { transpose_item_f8(w_down, 4096, 1024, (unsigned char*)WdnT, scr, r, lane, WDN_SCALE); continue; } r -= I_DN;
            { const int q = r / I_C1, rr = r % I_C1, kv = q >> 1, a = q & 1; const float* W1 = kv ? w_cv1 : w_ck1;
              transpose_item<false>(W1 + (size_t)a * 1024 * 128, 1024, 128, Wc1T + (size_t)kv * 256 * 1024 + (size_t)a * 128 * 1024, 128, scr, rr, lane); }
        }
        for (int m = gw * 4; m < MTOK; m += NGW * 4) rms_rows_to_bf16<4>(x_ + (size_t)m * DM, g_mix_pre, NB + (size_t)m * DM, lane);
        for (int m = gw * 4; m < MMEM; m += NGW * 4) rms_rows_to_bf16<4>(mem_ + (size_t)m * DM, g_mem, MN + (size_t)m * DM, lane);
        for (int i = bx * 512 + tid; i < SEQ * 32; i += G * 512) { const int pos = i >> 5, k = i & 31;
            const float inv = powf(10000.0f, -(float)k / 32.0f); const float ang = (float)pos * inv; float sn, cs; sincosf(ang, &sn, &cs); ROPE[i] = (f32x2){cs, sn}; }
        for (int o_ = gw; o_ < 256; o_ += NGW) { const int kv = o_ >> 7, c = o_ & 127; const float* W1 = kv ? w_cv1 : w_ck1; const float* pe = kv ? pe_v : pe_k; float s = 0.f;
            for (int kk = lane; kk < 2048; kk += 64) s += pe[kk] * W1[(size_t)kk * 128 + c];
            s = wave_sum(s); if (lane == 0) BIAS1[o_] = s; }
    }
    SEAM(0);
    if (IN(1)) { PHASE_IDS;
        { pg8::Gemm g{(const char*)NB, (const char*)WinT, 1024, 1024, 128, 128, 1024}; pg8::StaticOrder S; S.init(MTOK, NPROJ, G, bx, 1024, 1024, NPROJ);
          pg8::EpiProj E{PROJ, FG}; pg8::gemm_phase(lds, g, S, E, tid); }
        { pg8::Gemm g{(const char*)MN, (const char*)WxkvT, 1024, 1024, 128, 128, 1024}; KvMemOrder S{G, bx}; EpiKvMem E{KX}; pg8::gemm_phase(lds, g, S, E, tid); }
    }
    SEAM(1);
    if (IN(2)) { PHASE_IDS;
        const int nb = G > 64 ? 64 : 0;
        if (bx < 64 || nb == 0) {
            pg8::Gemm g{(const char*)PROJ, (const char*)Wc1T, 16 * NPROJ, 1024, NPROJ * 2, 128, 1024}; CmpOrder S{nb ? 64 : G, bx}; pg8::EpiF32 E{Y, 256, 1.0f};
            pg8::gemm_phase(lds, g, S, E, tid);
        }
        if (bx >= nb) {
            const int egw = (bx - nb) * NWAVES + wave, ENGW = (G - nb) * NWAVES;
            for (int s = egw; s < BATCH * 8; s += ENGW) { const int b = s >> 3, h = s & 7; const float bf = b_forget[h];
                const float* fp = FG + ((size_t)b * SEQ + lane * 32) * 32 + h; float v[32]; float run = 0.f;
#pragma unroll
                for (int i = 0; i < 32; ++i) { const float z = fp[(size_t)i * 32] + bf; const float ls = fminf(z, 0.f) - log1pf(expf(-fabsf(z))); run += ls; v[i] = run; }
                float incl = run;
#pragma unroll
                for (int o_ = 1; o_ < 64; o_ <<= 1) { const float t = __shfl_up(incl, o_); if (lane >= o_) incl += t; }
                const float excl = incl - run; float* cp = C2B + (size_t)s * SEQ + lane * 32;
#pragma unroll
                for (int i = 0; i < 32; ++i) cp[i] = (v[i] + excl) * att::LOG2E; }
            for (int tsk = egw; tsk < BATCH * 8 * 32; tsk += ENGW) { const int bh = tsk >> 5, ch = tsk & 31, b = bh >> 3, h = bh & 7;
                const bf16_t* base = PROJ + ((size_t)b * SEQ + ch * 64 + (lane >> 3)) * NPROJ + h * 64 + (lane & 7) * 8; float mq = 0.f, mk = 0.f;
#pragma unroll
                for (int p = 0; p < 8; ++p) { const u32x4 wq = *(const u32x4*)(base + (size_t)p * 8 * NPROJ + C_FQ), wk = *(const u32x4*)(base + (size_t)p * 8 * NPROJ + C_FK); float sq = 0.f, sk = 0.f;
#pragma unroll
                    for (int i = 0; i < 4; ++i) { const float a = bf_lo(wq[i]), c = bf_hi(wq[i]), d = bf_lo(wk[i]), e = bf_hi(wk[i]); sq += a * a + c * c; sk += d * d + e * e; }
                    sq += __shfl_xor(sq, 1); sq += __shfl_xor(sq, 2); sq += __shfl_xor(sq, 4); sk += __shfl_xor(sk, 1); sk += __shfl_xor(sk, 2); sk += __shfl_xor(sk, 4);
                    mq = fmaxf(mq, sq); mk = fmaxf(mk, sk); }
                mq = wave_max(mq); mk = wave_max(mk);
                if (lane == 0) { atomicMax(&ctl[CW_NORM + 2 * bh], __float_as_uint(mq)); atomicMax(&ctl[CW_NORM + 2 * bh + 1], __float_as_uint(mk)); } }
            for (int m = egw; m < MTOK; m += ENGW) { const int pos = m & (SEQ - 1); const int cl = 4 * (lane & 31);
                bf16_t* p = PROJ + (size_t)m * NPROJ + (lane < 32 ? C_KS : C_KW) + cl; const int i0 = (cl & 63) >> 1;
                const u32x2 w = *(const u32x2*)p; const f32x2 cs0 = ROPE[pos * 32 + i0], cs1 = ROPE[pos * 32 + i0 + 1]; u32x2 o;
                { const float x1 = bf_lo(w.x), x2 = bf_hi(w.x); o.x = pk2(x1 * cs0.x - x2 * cs0.y, x2 * cs0.x + x1 * cs0.y); }
                { const float x1 = bf_lo(w.y), x2 = bf_hi(w.y); o.y = pk2(x1 * cs1.x - x2 * cs1.y, x2 * cs1.x + x1 * cs1.y); }
                *(u32x2*)p = o; }
        }
    }
    SEAM(2);
    if (IN(3)) { PHASE_IDS;
        LAS float* hs = (LAS float*)(lds + wave * 512);
        for (int idx = gw; idx < 4 * BATCH * 128; idx += NGW) { const int z = idx >> 12, rem = idx & 4095, b = rem >> 7, n = rem & 127, g = z >> 1, kv = z & 1;
            bf16_t* dst = KC + (((size_t)(b * 2 + g) * 2 + kv) * 128 + n) * 64;
            if (n == 127) { dst[lane] = 0; continue; }
            const float* y0 = Y + ((size_t)z * 4096 + b * 128 + n) * 256; const float* y1 = y0 + 256 + 128;
#pragma unroll
            for (int q = 0; q < 2; ++q) { const int c = lane + 64 * q; const float a = y0[c] + y1[c] + BIAS1[kv * 128 + c]; hs[c] = a / (1.f + __expf(-a)); }
            asm volatile("s_waitcnt lgkmcnt(0)" ::: "memory");
            const float* W2 = kv ? w_cv2 : w_ck2; const int js = kv ? lane : ((lane >> 1) + 32 * (lane & 1)); float acc = 0.f;
#pragma unroll 8
            for (int c = 0; c < 128; ++c) acc += hs[c] * W2[c * 64 + js];
            dst[lane] = (bf16_t)(pk2(acc, 0.f) & 0xffffu);
            asm volatile("s_waitcnt lgkmcnt(0)" ::: "memory"); }
    }
    SEAM(3);
    if (IN(4)) { PHASE_IDS;
        LAS int* qw = (LAS int*)(lds + att::L_MISC);
        const int myq = (int)(xb_xcc_id() & 7u);
        for (int qi = 0; qi < 8; ++qi) {
            const int q = (myq + qi) & 7;
            for (;;) {
                if (tid == 0) qw[0] = (int)atomicAdd(&ctl[CW_QUEUE + 64 * q], 1u);
                __syncthreads();
                const int u = qw[0];
                __syncthreads();
                if (u >= 512) break;
                const int b = q + 8 * (u >> 7), r = u & 127;
                if (r < 64) att::nsa_unit(lds, b, r & 1, 31 - (r >> 1), PROJ, KC, FG, ROPE, AO, wave, lane);
                else { const int v = r - 64; att::fox_unit(lds, b, v & 7, 7 - (v >> 3), PROJ, C2B, (const float*)(ctl + CW_NORM + 2 * (b * 8 + (v & 7))), AO, wave, lane); }
            }
        }
    }
    SEAM(4);
    if (IN(5)) { PHASE_IDS; pg8::Gemm g{(const char*)AO, (const char*)WoutT, 1024, 1024, 128, 128, 1024}; pg8::StaticOrder S; S.init(MTOK, 1024, G, bx, 1024, 1024, 1024);
        pg8::EpiResid<false, true, true> E{x_, H1B, g_mix_post, RSTD2, XSB, ctl + CW_XCNT, lds + 131072}; pg8::gemm_phase(lds, g, S, E, tid); }
    SEAM(5);
    if (IN(7)) { PHASE_IDS; pg8::Gemm g{(const char*)H1B, (const char*)WxqT, 1024, 1024, 128, 128, 1024}; pg8::StaticOrder S; S.init(MTOK, 1024, G, bx, 1024, 1024, 1024);
        pg8::EpiBf16<0> E{QX, 1024, RSTD2}; pg8::gemm_phase(lds, g, S, E, tid); }
    SEAM(7);
    if (IN(8)) { PHASE_IDS; pg8::Gemm g{(const char*)QX, (const char*)KX, 1024, 1024, 128, 128, 256}; XAttnOrder S{G, bx, false};
        pg8::EpiSoftmax E{PB, 1024, 0.0625f * att::LOG2E, lds + 131072}; pg8::gemm_phase(lds, g, S, E, tid); }
    SEAM(8);
    if (IN(10)) { PHASE_IDS; pg8::Gemm g{(const char*)PB, (const char*)VT, 1024, 8192, 128, 128, 256}; XAttnOrder S{G, bx, true};
        pg8::EpiBf16<0> E{XOIN, 1024}; pg8::gemm_phase(lds, g, S, E, tid); }
    SEAM(10);
    if (IN(11)) { PHASE_IDS; pg8::Gemm g{(const char*)XOIN, (const char*)WxoT, 1024, 1024, 128, 128, 1024}; pg8::StaticOrder S; S.init(MTOK, 1024, G, bx, 1024, 1024, 1024);
        pg8::EpiResid<true, true, true> E{H1B, GB, g_x_post, RSTD3, XSB + (size_t)2 * MTOK * 4, ctl + CW_XCNT + 2 * 256 * 64, lds + 131072}; pg8::gemm_phase(lds, g, S, E, tid); }
    SEAM(11);
    if (IN(13)) { PHASE_IDS; pg8::Gemm g{(const char*)GB, (const char*)WupT, 1024, 1024, 128, 128, 1024}; pg8::StaticOrder S; S.init(MTOK, FF, G, bx, 1024, 1024, FF);
        pg8::EpiF8Relu2 E{(unsigned char*)UB, FF, RSTD3}; pg8::gemm_phase(lds, g, S, E, tid); }
    SEAM(13);
    if (IN(14)) { PHASE_IDS; pg8::Gemm g{(const char*)UB, (const char*)WdnT, FF / 2, FF / 2, 128, 128, FF / 2}; pg8::StaticOrder S; S.init(MTOK, 1024, G, bx, FF / 2, FF / 2, 1024);
        pg8::EpiResid<true, false, false, WDN_SHIFT> E{GB, OUTP, g_mlp_post, nullptr, XSB + (size_t)4 * MTOK * 4, ctl + CW_XCNT + 4 * 256 * 64, lds + 131072}; pg8::gemm_phase<true>(lds, g, S, E, tid); }
#undef IN
#undef SEAM
}

extern "C" void kernel_launch(void* const* d_in, const int* in_sizes, int n_in, void* d_out, int out_size, void* d_ws, size_t ws_size, hipStream_t stream) {
    static int grid = 0;
    if (grid == 0) {
        if (n_in != 23 || out_size != MTOK * DM || ws_size < WS_END) { fprintf(stderr, "kernel_launch: unexpected problem (n_in %d, out %d, ws %zu)\n", n_in, out_size, ws_size); grid = -1; return; }
        int dev = 0, cus = 0, per_cu = 0;
        hipGetDevice(&dev); hipDeviceGetAttribute(&cus, hipDeviceAttributeMultiprocessorCount, dev);
        if (hipFuncSetAttribute((const void*)layer_fwd, hipFuncAttributeMaxDynamicSharedMemorySize, LDS_BYTES) != hipSuccess) { fprintf(stderr, "kernel_launch: hipFuncSetAttribute failed\n"); grid = -1; return; }
        if (hipOccupancyMaxActiveBlocksPerMultiprocessor(&per_cu, (const void*)layer_fwd, NWAVES * 64, LDS_BYTES) != hipSuccess || per_cu < 1) { fprintf(stderr, "kernel_launch: occupancy query says %d\n", per_cu); per_cu = 1; }
        (void)hipGetLastError();
        grid = cus;
    }
    if (grid < 0) return;
    if (hipMemsetAsync((char*)d_ws + WS_CTL, 0, 1 << 20, stream) != hipSuccess) { fprintf(stderr, "kernel_launch: memset failed\n"); return; }
    Args a{};
    for (int i = 0; i < 23; ++i) a.in[i] = (const float*)d_in[i];
    a.out = (float*)d_out; a.ws = (unsigned char*)d_ws;
#if MK_ONE_LAUNCH
    a.ph_lo = 0; a.ph_hi = NPHASE;
    void* kargs[] = {&a};
    hipError_t e = hipLaunchCooperativeKernel((const void*)layer_fwd, dim3(grid), dim3(NWAVES * 64), kargs, LDS_BYTES, stream);
    if (e != hipSuccess) fprintf(stderr, "kernel_launch: cooperative launch failed: %s (grid %d)\n", hipGetErrorString(e), grid);
#else
    for (int p = 0; p < NPHASE; ++p) { a.ph_lo = p; a.ph_hi = p + 1; hipLaunchKernelGGL(layer_fwd, dim3(grid), dim3(NWAVES * 64), LDS_BYTES, stream, a); }
#endif
}
```
